# Optimizing an MI355X kernel written in HIP

```python
import math
import jax
import jax.numpy as jnp
from jax import lax
import numpy as np

D_MODEL = 1024
BATCH = 32
SEQ = 2048
DEPTH = 2
DEC_BATCH = 32
DEC_SEQ = 16
PAST_LEN = 2048

CHUNK = 64
N_EVEN = (DEPTH + 1) // 2
N_ODD = DEPTH // 2
HEAD_DIM = 64
MIX_WIDTH = D_MODEL
FOX_WIDTH = MIX_WIDTH // 2
FOX_HEADS = FOX_WIDTH // HEAD_DIM
RW_WIDTH = MIX_WIDTH - FOX_WIDTH
RW_HEADS = RW_WIDTH // HEAD_DIM
W_LORA = 64
A_LORA = 64
G_LORA = 128
FOX_COLS = 3 * FOX_WIDTH + FOX_HEADS
RW_OFF_W = 3 * RW_WIDTH
RW_OFF_A = RW_OFF_W + W_LORA
RW_OFF_G = RW_OFF_A + A_LORA
RW_COLS = RW_OFF_G + G_LORA
EVEN_IN = FOX_COLS + RW_COLS
Q_BLOCK = 128
GM_CHUNK = 128
GM_GROUPS = 8
GM_WIDTH = D_MODEL
GM_GDIM = GM_WIDTH // GM_GROUPS
D_FF = 2816
FFN_RES_SCALE = 0.5
RMS_EPS = 1e-6
LN_EPS = 1e-5
GN_EPS = 64e-5

kernel_name = 'fox_rwkv7_gmlp_streaming_step'


def rms_norm(x, g):
    xf = x.astype(jnp.float32)
    y = xf * lax.rsqrt(jnp.mean(xf * xf, axis=-1, keepdims=True) + RMS_EPS)
    return (y * g.astype(jnp.float32)).astype(x.dtype)


def layer_norm(x, g, b):
    xf = x.astype(jnp.float32)
    m = jnp.mean(xf, axis=-1, keepdims=True)
    var = jnp.mean(jnp.square(xf - m), axis=-1, keepdims=True)
    y = (xf - m) * lax.rsqrt(var + LN_EPS)
    return (y * g.astype(jnp.float32) + b.astype(jnp.float32)).astype(x.dtype)


def swiglu(h, w_in, w_out):
    gate, up = jnp.split(h @ w_in, 2, axis=-1)
    return (jax.nn.silu(gate) * up) @ w_out


def macaron_half(x, g_pre, g_post, w_in, w_out):
    return x + FFN_RES_SCALE * rms_norm(swiglu(rms_norm(x, g_pre), w_in, w_out), g_post)


def fox_block(q, k, v, cq, ck, qpos, kpos):
    s = jnp.einsum('bqhd,bkhd->bhqk', q, k).astype(jnp.float32) * (HEAD_DIM ** -0.5)
    bias = jnp.swapaxes(cq, 1, 2)[..., :, None] - jnp.swapaxes(ck, 1, 2)[..., None, :]
    mask = kpos[None, :] <= qpos[:, None]
    p = jax.nn.softmax(jnp.where(mask, s + bias, -jnp.inf), axis=-1)
    return jnp.einsum('bhqk,bkhd->bqhd', p.astype(v.dtype), v)


def fox_prompt(q, k, v, logf):
    t_len = q.shape[1]
    c = jnp.cumsum(logf, axis=1)
    pos = jnp.arange(t_len)
    outs = []
    for i in range(t_len // Q_BLOCK):
        lo, hi = i * Q_BLOCK, (i + 1) * Q_BLOCK
        outs.append(fox_block(q[:, lo:hi], k[:, :hi], v[:, :hi], c[:, lo:hi], c[:, :hi], pos[lo:hi], pos[:hi]))
    return jnp.concatenate(outs, axis=1)


def fox_sample(q, k, v, logf, ck, cv, clogf):
    p_len = ck.shape[1]
    t_len = q.shape[1]
    k_all = jnp.concatenate([ck.astype(k.dtype), k], axis=1)
    v_all = jnp.concatenate([cv.astype(v.dtype), v], axis=1)
    c = jnp.cumsum(jnp.concatenate([clogf.astype(jnp.float32), logf], axis=1), axis=1)
    pos = jnp.arange(p_len + t_len)
    return fox_block(q, k_all, v_all, c[:, p_len:], c, pos[p_len:], pos)


def rwkv7_scan(s0, r, w, k, v, a_, b_):
    def step(s, inp):
        r_t, w_t, k_t, v_t, a_t, b_t = inp
        sa = jnp.einsum('bhij,bhj->bhi', s, a_t)
        s = s * w_t[:, :, None, :] + sa[..., :, None] * b_t[:, :, None, :] + v_t[..., :, None] * k_t[:, :, None, :]
        return s, jnp.einsum('bhij,bhj->bhi', s, r_t)
    xs = tuple(jnp.swapaxes(t, 0, 1) for t in (r, w, k, v, a_, b_))
    s_fin, ys = lax.scan(step, s0, xs)
    return s_fin, jnp.swapaxes(ys, 0, 1)


def even_mixer(h, w_in, fox_bf, rw_mu, rw_w0, rw_w2, rw_a0, rw_a2, rw_g2, rw_kk, rw_ka, rw_rk,
               rw_ln_g, rw_ln_b, w_out, past):
    f32 = jnp.float32
    bsz, t_len, _ = h.shape
    proj = h @ w_in
    pf = proj[..., :FOX_COLS]
    pr = proj[..., FOX_COLS:]
    fh = lambda t: t.reshape(bsz, t_len, FOX_HEADS, HEAD_DIM)
    q = fh(pf[..., :FOX_WIDTH])
    k = fh(pf[..., FOX_WIDTH:2 * FOX_WIDTH])
    v = fh(pf[..., 2 * FOX_WIDTH:3 * FOX_WIDTH])
    logf = jax.nn.log_sigmoid(pf[..., 3 * FOX_WIDTH:].astype(f32) + fox_bf.astype(f32))
    if past is None:
        o_fox = fox_prompt(q, k, v, logf)
        prev = jnp.zeros((bsz, 1, RW_COLS), pr.dtype)
        s0 = jnp.zeros((bsz, RW_HEADS, HEAD_DIM, HEAD_DIM), f32)
    else:
        ck, cv, clogf, s_in, prev = past
        o_fox = fox_sample(q, k, v, logf, ck, cv, clogf)
        s0 = s_in.astype(f32)
    prev_seq = jnp.concatenate([prev.astype(pr.dtype), pr[:, :-1]], axis=1)
    xm = pr + (prev_seq - pr) * rw_mu
    r = xm[..., :RW_WIDTH].astype(f32)
    kx = xm[..., RW_WIDTH:2 * RW_WIDTH].astype(f32)
    vx = xm[..., 2 * RW_WIDTH:RW_OFF_W].astype(f32)
    dw = xm[..., RW_OFF_W:RW_OFF_A]
    da = xm[..., RW_OFF_A:RW_OFF_G]
    dg = xm[..., RW_OFF_G:]
    w_log = -jax.nn.softplus(-(rw_w0 + jnp.tanh(dw) @ rw_w2).astype(f32)) - 0.5
    decay = jnp.exp(-jnp.exp(w_log))
    a = jax.nn.sigmoid((rw_a0 + da @ rw_a2).astype(f32))
    g = (jax.nn.sigmoid(dg) @ rw_g2).astype(f32)
    rh = lambda t: t.reshape(bsz, t_len, RW_HEADS, HEAD_DIM)
    kk = rh(kx * rw_kk.astype(f32))
    kk = kk / jnp.maximum(jnp.linalg.norm(kk, axis=-1, keepdims=True), 1e-12)
    k_mod = rh(kx * (1.0 + (a - 1.0) * rw_ka.astype(f32)))
    r_h = rh(r)
    v_h = rh(vx)
    s_fin, y = rwkv7_scan(s0, r_h, rh(decay), k_mod, v_h, -kk, kk * rh(a))
    ym = jnp.mean(y, axis=-1, keepdims=True)
    yv = jnp.mean(jnp.square(y - ym), axis=-1, keepdims=True)
    y = ((y - ym) * lax.rsqrt(yv + GN_EPS)).reshape(bsz, t_len, RW_WIDTH)
    y = y * rw_ln_g.astype(f32) + rw_ln_b.astype(f32)
    bonus = jnp.sum(r_h * k_mod * rw_rk.astype(f32), axis=-1, keepdims=True) * v_h
    y = (y + bonus.reshape(bsz, t_len, RW_WIDTH)) * g
    mixed = jnp.concatenate([o_fox.reshape(bsz, t_len, FOX_WIDTH), y.astype(h.dtype)], axis=-1)
    out = mixed @ w_out
    new_state = (k, v, logf.astype(h.dtype), s_fin.astype(h.dtype), pr[:, -1:])
    return out, new_state


def odd_mixer(h, w_in, ln_g, ln_b, w_s, b_s, w_out, is_prompt):
    bsz, t_len, _ = h.shape
    u, v = jnp.split(jax.nn.gelu(h @ w_in, approximate=False), 2, axis=-1)
    v = layer_norm(v, ln_g, ln_b)
    cpos = jnp.arange(GM_CHUNK) // CHUNK
    wm = jnp.where(cpos[None, :] <= cpos[:, None], w_s, 0.0).astype(v.dtype)
    if is_prompt:
        vg = v.reshape(bsz, t_len // GM_CHUNK, GM_CHUNK, GM_GROUPS, GM_GDIM)
        sp = jnp.einsum('gts,bnsgc->bntgc', wm, vg) + b_s.T[None, None, :, :, None]
    else:
        vg = v.reshape(bsz, t_len, GM_GROUPS, GM_GDIM)
        sp = jnp.einsum('gts,bsgc->btgc', wm[:, :t_len, :t_len], vg) + b_s[:, :t_len].T[None, :, :, None]
    sp = sp.reshape(bsz, t_len, GM_WIDTH).astype(u.dtype)
    return (u * sp) @ w_out, v


def setup_inputs(seed: int = 0) -> dict:
    key = jax.random.key(seed)
    ks = jax.random.split(key, 32)
    f32 = jnp.float32
    nrm = lambda i, shape, scale: jax.random.normal(ks[i], shape, f32) * scale
    return {
        'x_prompt': nrm(0, (BATCH, SEQ, D_MODEL), 1.0),
        'x_sample': nrm(1, (DEC_BATCH, DEC_SEQ, D_MODEL), 1.0),
        'cache_fox_k': nrm(2, (N_EVEN, DEC_BATCH, PAST_LEN, FOX_HEADS, HEAD_DIM), 1.0),
        'cache_fox_v': nrm(3, (N_EVEN, DEC_BATCH, PAST_LEN, FOX_HEADS, HEAD_DIM), 1.0),
        'cache_fox_logf': jax.nn.log_sigmoid(nrm(4, (N_EVEN, DEC_BATCH, PAST_LEN, FOX_HEADS), 1.0) + 2.0),
        'state_rwkv': nrm(5, (N_EVEN, DEC_BATCH, RW_HEADS, HEAD_DIM, HEAD_DIM), 1.0),
        'state_rwkv_shift': nrm(6, (N_EVEN, DEC_BATCH, 1, RW_COLS), 1.0),
        'norm_g': 1.0 + nrm(7, (DEPTH, 6, D_MODEL), 0.05),
        'ffn_w_in': nrm(8, (DEPTH, 2, D_MODEL, 2 * D_FF), D_MODEL ** -0.5),
        'ffn_w_out': nrm(9, (DEPTH, 2, D_FF, D_MODEL), D_FF ** -0.5),
        'even_w_in': nrm(10, (N_EVEN, D_MODEL, EVEN_IN), D_MODEL ** -0.5),
        'fox_bf': 2.0 + nrm(11, (N_EVEN, FOX_HEADS), 0.5),
        'rw_mu': jax.random.uniform(ks[12], (N_EVEN, RW_COLS), f32, 0.0, 1.0),
        'rw_w0': jax.random.uniform(ks[13], (N_EVEN, RW_WIDTH), f32, -6.0, -1.0),
        'rw_w2': nrm(14, (N_EVEN, W_LORA, RW_WIDTH), W_LORA ** -0.5),
        'rw_a0': nrm(15, (N_EVEN, RW_WIDTH), 0.1),
        'rw_a2': nrm(16, (N_EVEN, A_LORA, RW_WIDTH), A_LORA ** -0.5),
        'rw_g2': nrm(17, (N_EVEN, G_LORA, RW_WIDTH), G_LORA ** -0.5),
        'rw_kk': 0.85 + nrm(18, (N_EVEN, RW_WIDTH), 0.05),
        'rw_ka': 1.0 + nrm(19, (N_EVEN, RW_WIDTH), 0.05),
        'rw_rk': nrm(20, (N_EVEN, RW_HEADS, HEAD_DIM), 0.1),
        'rw_ln_g': 1.0 + nrm(21, (N_EVEN, RW_WIDTH), 0.05),
        'rw_ln_b': nrm(22, (N_EVEN, RW_WIDTH), 0.02),
        'even_w_out': nrm(23, (N_EVEN, MIX_WIDTH, D_MODEL), MIX_WIDTH ** -0.5),
        'gm_w_in': nrm(24, (N_ODD, D_MODEL, 2 * GM_WIDTH), D_MODEL ** -0.5),
        'gm_ln_g': 1.0 + nrm(25, (N_ODD, GM_WIDTH), 0.05),
        'gm_ln_b': nrm(26, (N_ODD, GM_WIDTH), 0.02),
        'gm_w_s': nrm(27, (N_ODD, GM_GROUPS, GM_CHUNK, GM_CHUNK), GM_CHUNK ** -0.5),
        'gm_b_s': 1.0 + nrm(28, (N_ODD, GM_GROUPS, GM_CHUNK), 0.1),
        'gm_w_out': nrm(29, (N_ODD, GM_WIDTH, D_MODEL), GM_WIDTH ** -0.5),
    }


def reference(x_prompt, x_sample, cache_fox_k, cache_fox_v, cache_fox_logf, state_rwkv, state_rwkv_shift,
              norm_g, ffn_w_in, ffn_w_out, even_w_in, fox_bf, rw_mu, rw_w0, rw_w2, rw_a0, rw_a2, rw_g2,
              rw_kk, rw_ka, rw_rk, rw_ln_g, rw_ln_b, even_w_out, gm_w_in, gm_ln_g, gm_ln_b, gm_w_s,
              gm_b_s, gm_w_out):
    xp, xs = x_prompt, x_sample
    fk_p, fv_p, fl_p, rs_p, rsh_p = [], [], [], [], []
    fk_s, fv_s, fl_s, rs_s, rsh_s = [], [], [], [], []
    gv_s = []
    for layer in range(DEPTH):
        j = layer // 2
        ng = norm_g[layer]
        xp = macaron_half(xp, ng[0], ng[1], ffn_w_in[layer, 0], ffn_w_out[layer, 0])
        xs = macaron_half(xs, ng[0], ng[1], ffn_w_in[layer, 0], ffn_w_out[layer, 0])
        if layer % 2 == 0:
            ew = (even_w_in[j], fox_bf[j], rw_mu[j], rw_w0[j], rw_w2[j], rw_a0[j], rw_a2[j], rw_g2[j],
                  rw_kk[j], rw_ka[j], rw_rk[j], rw_ln_g[j], rw_ln_b[j], even_w_out[j])
            mp, stp = even_mixer(rms_norm(xp, ng[2]), *ew, None)
            ms, sts = even_mixer(rms_norm(xs, ng[2]), *ew,
                                 (cache_fox_k[j], cache_fox_v[j], cache_fox_logf[j], state_rwkv[j], state_rwkv_shift[j]))
            for lst, val in zip((fk_p, fv_p, fl_p, rs_p, rsh_p), stp):
                lst.append(val)
            for lst, val in zip((fk_s, fv_s, fl_s, rs_s, rsh_s), sts):
                lst.append(val)
        else:
            ow = (gm_w_in[j], gm_ln_g[j], gm_ln_b[j], gm_w_s[j], gm_b_s[j], gm_w_out[j])
            mp, _ = odd_mixer(rms_norm(xp, ng[2]), *ow, True)
            ms, v_new = odd_mixer(rms_norm(xs, ng[2]), *ow, False)
            gv_s.append(v_new)
        xp = xp + rms_norm(mp, ng[3])
        xs = xs + rms_norm(ms, ng[3])
        xp = macaron_half(xp, ng[4], ng[5], ffn_w_in[layer, 1], ffn_w_out[layer, 1])
        xs = macaron_half(xs, ng[4], ng[5], ffn_w_in[layer, 1], ffn_w_out[layer, 1])
    return (xp, xs,
            jnp.stack(fk_p), jnp.stack(fv_p), jnp.stack(fl_p), jnp.stack(rs_p), jnp.stack(rsh_p),
            jnp.stack(fk_s), jnp.stack(fv_s), jnp.stack(fl_s), jnp.stack(rs_s), jnp.stack(rsh_s),
            jnp.stack(gv_s))
```

```cpp
#include <hip/hip_runtime.h>
#include <hip/hip_cooperative_groups.h>
#include <cstdio>
#include <cstdint>
namespace cg = cooperative_groups;
namespace pg8 {
#define PG8_LAS __attribute__((address_space(3)))
typedef unsigned short bf16_t;
typedef short bf16x8 __attribute__((ext_vector_type(8)));
typedef float f32x4 __attribute__((ext_vector_type(4)));
typedef unsigned u32x4 __attribute__((ext_vector_type(4)));
constexpr int BM = 256, BK = 64, HALF = 128, HTB = HALF * BK * 2  , STAGE_BYTES = 8 * HTB, NXCD = 8, WGM = 8;

__host__ __device__ __forceinline__ int lds_byte(int r, int c) { const int st = (r >> 4) * 2 + (c >> 5), rr = r & 15, cc = c & 31, ob = rr * 64 + cc * 2; return st * 1024 + (ob ^ (((ob >> 9) & 1) << 5)); }
__host__ __device__ __forceinline__ void stage_rc(int b, int& R, int& C) { const int st = b / 1024, sb = b % 1024, swz = sb ^ (((sb >> 9) & 1) << 5); R = (st >> 1) * 16 + swz / 64; C = (st & 1) * 32 + (swz % 64) / 2; }
__host__ __device__ __forceinline__ int perm32(int rho) { const int n = rho >> 4, i = rho & 15; return 8 * (i >> 2) + 4 * n + (i & 3); }

struct Unit { int pm, pn; };
struct Gemm { const bf16_t* A; const bf16_t* Bt; int M, N, K; };

struct StaticOrder {
    int nM, nN, nwg, G, c;
    __host__ __device__ void init(int M, int N, int G_, int c_) { nM = M / BM; nN = N / BM; nwg = nM * nN; G = G_; c = c_; }
    __host__ __device__ bool next(int i, Unit& u) const {
        const long L = (long)i * G + c; if (L >= nwg) return false;
        int wgid = (int)L; { const int q = nwg / NXCD, r = nwg % NXCD, xcd = wgid % NXCD, off = wgid / NXCD; wgid = (xcd < r ? xcd * (q + 1) : r * (q + 1) + (xcd - r) * q) + off; }
        const int nig = WGM * nN, gid = wgid / nig, fm = gid * WGM, gsz = (nM - fm) < WGM ? (nM - fm) : WGM;
        u.pm = fm + ((wgid % nig) % gsz); u.pn = (wgid % nig) / gsz; return true;
    }
    __device__ __forceinline__ void a_ready(const Unit&) const {}
    __device__ __forceinline__ void done(const Unit&) const {}
};
__device__ __forceinline__ unsigned cvt_pk_bf16(float lo, float hi) { unsigned r; asm volatile("v_cvt_pk_bf16_f32 %0, %1, %2" : "=v"(r) : "v"(lo), "v"(hi)); return r; }
typedef float f32x2 __attribute__((ext_vector_type(2)));
__device__ __forceinline__ f32x2 gelu_pk(f32x2 v) {
    const f32x2 av = __builtin_elementwise_abs(v), d = av * 0.2316418882f + 1.0f;
    f32x2 t; t.x = __builtin_amdgcn_rcpf(d.x); t.y = __builtin_amdgcn_rcpf(d.y);
    f32x2 q = t * 0.5307027145f + (-0.7265760135f); q = q * t + 0.7107068705f; q = q * t + (-0.142248368f); q = q * t + 0.127414796f; q = q * t;
    const f32x2 s = (v * v) * (-0.72134752044f);
    f32x2 e; e.x = __builtin_amdgcn_exp2f(s.x); e.y = __builtin_amdgcn_exp2f(s.y);
    const f32x2 m = v * (q * e), r = v - m;
    f32x2 o; o.x = v.x < 0.f ? m.x : r.x; o.y = v.y < 0.f ? m.y : r.y; return o;
}

template <class Epi, class Sched, bool ALIGN_EPI = true, bool SP2 = true>
__device__ __forceinline__ void gemm_phase(PG8_LAS unsigned char* lds, const Gemm g, const Sched& S, const Epi& E, const int tid) {
    const int wid = __builtin_amdgcn_readfirstlane(tid >> 6), lane = tid & 63, wr = wid >> 2, wc = wid & 3, fr = lane & 15, fq = lane >> 4;
    const int K = g.K, nt = K / BK;
    unsigned voffA[2], voffB[2];
#pragma unroll
    for (int i = 0; i < 2; ++i) { int R, C; stage_rc(tid * 16 + i * 8192, R, C); const int Rb = Epi::PERM ? ((R & ~31) + perm32(R & 31)) : R;
        voffA[i] = (unsigned)(R * K + C) * 2u; voffB[i] = (unsigned)(Rb * K + C) * 2u; }
    const size_t kstep = (size_t)(BK * 2);
    const size_t hstep = (size_t)HALF * K * 2;
    const size_t tstep = 2 * hstep;
    const unsigned ldsw = (unsigned)wid * 1024u;
    const int aoff = lds_byte(wr * 64 + fr, fq * 8), boff = lds_byte(wc * 32 + fr, fq * 8);
#define PG8_SA(b, h) (((b) * 2 + (h)) * HTB)
#define PG8_SB(b, h) ((4 + (b) * 2 + (h)) * HTB)
#define PG8_STAGE(bufoff, gbase, voff) do { _Pragma("unroll") for (int _i = 0; _i < 2; ++_i) \
        __builtin_amdgcn_global_load_lds((const unsigned*)((const char*)(gbase) + (voff)[_i]), (PG8_LAS unsigned*)(lds + (bufoff) + ldsw + _i * 8192), 16, 0, 0); } while (0)
#define PG8_LDA(dst, b, h) do { _Pragma("unroll") for (int m = 0; m < 4; ++m) _Pragma("unroll") for (int k = 0; k < 2; ++k) dst[m][k] = *(const PG8_LAS bf16x8*)(lds + PG8_SA(b, h) + aoff + m * 2048 + k * 1024); } while (0)
#define PG8_LDB(dst, b, h) do { _Pragma("unroll") for (int n = 0; n < 2; ++n) _Pragma("unroll") for (int k = 0; k < 2; ++k) dst[n][k] = *(const PG8_LAS bf16x8*)(lds + PG8_SB(b, h) + boff + n * 2048 + k * 1024); } while (0)
#define PG8_MMA(ai, bj, At, Bt) do { __builtin_amdgcn_s_setprio(1); _Pragma("unroll") for (int m = 0; m < 4; ++m) _Pragma("unroll") for (int n = 0; n < 2; ++n) _Pragma("unroll") for (int k = 0; k < 2; ++k) \
        acc[ai][bj][m][n] = __builtin_amdgcn_mfma_f32_16x16x32_bf16(Bt[n][k], At[m][k], acc[ai][bj][m][n], 0, 0, 0); __builtin_amdgcn_s_setprio(0); } while (0)
#define PG8_WAIT_V(n) asm volatile("s_waitcnt vmcnt(" #n ")" ::: "memory")
#define PG8_WAIT_L(n) asm volatile("s_waitcnt lgkmcnt(" #n ")" ::: "memory")
#define PG8_BAR __builtin_amdgcn_s_barrier()
#define PG8_SCHED __builtin_amdgcn_sched_barrier(0)
    Unit cur, nxt; int ui = 0;
    if (!S.next(0, cur)) return;
    f32x4 acc[2][2][4][2];
#pragma unroll
    for (int a = 0; a < 2; ++a)
#pragma unroll
        for (int b = 0; b < 2; ++b)
#pragma unroll
            for (int m = 0; m < 4; ++m)
#pragma unroll
                for (int n = 0; n < 2; ++n) acc[a][b][m][n] = (f32x4){0.f, 0.f, 0.f, 0.f};
    bf16x8 At[4][2], B0[2][2], B1[2][2];
    const char* cA = (const char*)g.A + (size_t)cur.pm * tstep; const char* cB = (const char*)g.Bt + (size_t)cur.pn * tstep;
    S.a_ready(cur);
    if constexpr (SP2) {
        PG8_STAGE(PG8_SB(0, 0), cB, voffB); PG8_STAGE(PG8_SB(0, 1), cB + hstep, voffB); PG8_STAGE(PG8_SA(0, 0), cA, voffA); PG8_STAGE(PG8_SA(0, 1), cA + hstep, voffA);
        if (wr == 1) PG8_BAR;
        PG8_WAIT_V(2); PG8_BAR;
        PG8_STAGE(PG8_SB(1, 0), cB + kstep, voffB); PG8_STAGE(PG8_SA(1, 0), cA + kstep, voffA); PG8_STAGE(PG8_SB(1, 1), cB + hstep + kstep, voffB);
        PG8_WAIT_V(6); PG8_BAR;
    } else {
        PG8_STAGE(PG8_SB(0, 0), cB, voffB); PG8_STAGE(PG8_SA(0, 0), cA, voffA); PG8_STAGE(PG8_SB(0, 1), cB + hstep, voffB); PG8_STAGE(PG8_SA(0, 1), cA + hstep, voffA);
        if (wr == 1) PG8_BAR;
        PG8_WAIT_V(4); PG8_BAR;
        PG8_STAGE(PG8_SB(1, 0), cB + kstep, voffB); PG8_STAGE(PG8_SA(1, 0), cA + kstep, voffA); PG8_STAGE(PG8_SB(1, 1), cB + hstep + kstep, voffB);
        PG8_WAIT_V(6); PG8_BAR;
    }
    for (;;) {
        const bool has_next = S.next(ui + 1, nxt);
        const char* nA = has_next ? (const char*)g.A + (size_t)nxt.pm * tstep : cA; const char* nB = has_next ? (const char*)g.Bt + (size_t)nxt.pn * tstep : cB;
        for (int t = 0; t < nt; t += 2) {
            const bool last = (t == nt - 2);
            const char* a1 = cA + (size_t)(t + 1) * kstep;
            const char* a2 = last ? nA : cA + (size_t)(t + 2) * kstep; const char* b2 = last ? nB : cB + (size_t)(t + 2) * kstep;
            const char* a3 = a2 + kstep; const char* b3 = b2 + kstep;
            if (last && has_next) S.a_ready(nxt);
            if constexpr (SP2) {
            PG8_LDB(B0, 0, 0); PG8_LDB(B1, 0, 1); PG8_SCHED; PG8_LDA(At, 0, 0); PG8_STAGE(PG8_SA(1, 1), a1 + hstep, voffA);
            PG8_WAIT_V(8); PG8_WAIT_L(0); PG8_BAR; PG8_MMA(0, 0, At, B0); PG8_MMA(0, 1, At, B1); PG8_BAR; PG8_SCHED;
            PG8_LDA(At, 0, 1); PG8_STAGE(PG8_SB(0, 0), b2, voffB); PG8_STAGE(PG8_SB(0, 1), b2 + hstep, voffB); PG8_STAGE(PG8_SA(0, 0), a2, voffA);
            PG8_WAIT_V(8); PG8_WAIT_L(0); PG8_BAR; PG8_MMA(1, 0, At, B0); PG8_MMA(1, 1, At, B1); PG8_BAR; PG8_SCHED;
            PG8_LDB(B0, 1, 0); PG8_LDB(B1, 1, 1); PG8_SCHED; PG8_LDA(At, 1, 0); PG8_STAGE(PG8_SA(0, 1), a2 + hstep, voffA);
            PG8_WAIT_V(8); PG8_WAIT_L(0); PG8_BAR; PG8_MMA(0, 0, At, B0); PG8_MMA(0, 1, At, B1); PG8_BAR; PG8_SCHED;
            PG8_LDA(At, 1, 1); PG8_STAGE(PG8_SB(1, 0), b3, voffB); PG8_STAGE(PG8_SB(1, 1), b3 + hstep, voffB); PG8_STAGE(PG8_SA(1, 0), a3, voffA);
            PG8_WAIT_V(8); PG8_WAIT_L(0); PG8_BAR; PG8_MMA(1, 0, At, B0); PG8_MMA(1, 1, At, B1); PG8_BAR; PG8_SCHED;
            } else {
            PG8_LDB(B0, 0, 0); PG8_SCHED; PG8_LDA(At, 0, 0); PG8_STAGE(PG8_SA(1, 1), a1 + hstep, voffA);
            PG8_WAIT_L(8); PG8_BAR; PG8_WAIT_L(0); PG8_MMA(0, 0, At, B0); PG8_BAR; PG8_SCHED;
            PG8_LDB(B1, 0, 1); PG8_STAGE(PG8_SB(0, 0), b2, voffB);
            PG8_BAR; PG8_WAIT_L(0); PG8_MMA(0, 1, At, B1); PG8_BAR;
            PG8_LDA(At, 0, 1); PG8_STAGE(PG8_SA(0, 0), a2, voffA);
            PG8_BAR; PG8_WAIT_L(0); PG8_MMA(1, 0, At, B0); PG8_BAR; PG8_SCHED;
            PG8_STAGE(PG8_SB(0, 1), b2 + hstep, voffB);
            PG8_WAIT_V(6); PG8_BAR; PG8_MMA(1, 1, At, B1); PG8_BAR;
            PG8_LDB(B0, 1, 0); PG8_SCHED; PG8_LDA(At, 1, 0); PG8_STAGE(PG8_SA(0, 1), a2 + hstep, voffA);
            PG8_WAIT_L(8); PG8_BAR; PG8_WAIT_L(0); PG8_MMA(0, 0, At, B0); PG8_BAR; PG8_SCHED;
            PG8_LDB(B1, 1, 1); PG8_STAGE(PG8_SB(1, 0), b3, voffB);
            PG8_BAR; PG8_WAIT_L(0); PG8_MMA(0, 1, At, B1); PG8_BAR;
            PG8_LDA(At, 1, 1); PG8_STAGE(PG8_SA(1, 0), a3, voffA);
            PG8_BAR; PG8_WAIT_L(0); PG8_MMA(1, 0, At, B0); PG8_BAR; PG8_SCHED;
            PG8_STAGE(PG8_SB(1, 1), b3 + hstep, voffB);
            PG8_WAIT_V(6); PG8_BAR; PG8_MMA(1, 1, At, B1); PG8_BAR;
            }
        }
        if constexpr (ALIGN_EPI) { if (wr == 0) PG8_BAR; }
        if constexpr (!Epi::AFTER_DRAIN) { E(acc, cur, wr, wc, fr, fq); S.done(cur); }
        if (!has_next) break;
#pragma unroll
        for (int a = 0; a < 2; ++a)
#pragma unroll
            for (int b = 0; b < 2; ++b)
#pragma unroll
                for (int m = 0; m < 4; ++m)
#pragma unroll
                    for (int n = 0; n < 2; ++n) acc[a][b][m][n] = (f32x4){0.f, 0.f, 0.f, 0.f};
        cur = nxt; cA = nA; cB = nB; ++ui;
        if constexpr (ALIGN_EPI) { if (wr == 1) PG8_BAR; }
    }
    PG8_WAIT_V(0);
    if constexpr (!ALIGN_EPI) { if (wr == 0) PG8_BAR; }
    PG8_BAR;
    if constexpr (Epi::AFTER_DRAIN) { E.fused(acc, cur, wr, wc, fr, fq, lds, wid, lane); S.done(cur); }
#undef PG8_SA
#undef PG8_SB
#undef PG8_STAGE
#undef PG8_LDA
#undef PG8_LDB
#undef PG8_MMA
#undef PG8_WAIT_V
#undef PG8_WAIT_L
#undef PG8_BAR
#undef PG8_SCHED
}
}
#define LAS __attribute__((address_space(3)))
using pg8::bf16_t; using pg8::bf16x8; using pg8::f32x4; using pg8::u32x4; using pg8::f32x2; using pg8::cvt_pk_bf16;
typedef short s16x4 __attribute__((ext_vector_type(4)));
typedef unsigned u32x2 __attribute__((ext_vector_type(2)));
typedef short v4i16_t __attribute__((ext_vector_type(4)));

constexpr int DM = 1024, NB = 32, SEQ = 2048, MP = NB * SEQ, DSEQ = 16, MS = NB * DSEQ, M = MP + MS;
constexpr int FW = 512, RWC = 1792, DFF = 2816, NEI = 3584, PASTL = 2048, CTOT = PASTL + DSEQ;
constexpr float LOG2E = 1.4426950408889634f, QSCALE = 0.125f * LOG2E;
constexpr size_t O_YP = 0, O_YS = O_YP + (size_t)MP * DM, O_FKP = O_YS + (size_t)MS * DM, O_FVP = O_FKP + (size_t)MP * FW, O_FLP = O_FVP + (size_t)MP * FW,
    O_RSP = O_FLP + (size_t)MP * 8, O_RSHP = O_RSP + (size_t)NB * 8 * 64 * 64, O_FKS = O_RSHP + (size_t)NB * RWC, O_FVS = O_FKS + (size_t)MS * FW, O_FLS = O_FVS + (size_t)MS * FW,
    O_RSS = O_FLS + (size_t)MS * 8, O_RSHS = O_RSS + (size_t)NB * 8 * 64 * 64, O_GVS = O_RSHS + (size_t)NB * RWC, O_END = O_GVS + (size_t)MS * DM;
constexpr size_t MiB = 1u << 20, HMiB = 1u << 19, QMiB = 1u << 18;
constexpr size_t WS_WFI = 0, WS_WFO = 44 * MiB, WS_WEI = 66 * MiB, WS_WEO = 73 * MiB, WS_WGI = 75 * MiB, WS_WGO = 79 * MiB, WS_WLO = 81 * MiB, WS_WSM = 82 * MiB, WS_CUMP = 83 * MiB, WS_CUMS = 85 * MiB;
constexpr size_t WS_CTL = 88 * MiB, CTL_BYTES = 32768;
constexpr int CW_TAIL = 4096, N_TAIL = 8;
constexpr size_t WS_HN = 96 * MiB, WS_Y = 225 * MiB, WS_BIG = 483 * MiB, WS_KB = 838 * MiB, WS_VB = WS_KB + 129 * HMiB, WS_END = 1024 * MiB;
constexpr size_t WS_MIX = WS_HN, WS_DEC = WS_Y, WS_AA = WS_Y + 129 * MiB, WS_GG = WS_AA + 129 * HMiB;
constexpr size_t WS_QB = WS_BIG, WS_LA = WS_QB + 129 * HMiB, WS_PR = WS_LA + 129 * QMiB;
constexpr size_t WS_U = WS_BIG, WS_VR = WS_BIG + 129 * MiB, WS_UG = WS_HN;
static_assert((size_t)M * DM * 2 == 129 * MiB && (size_t)M * 512 * 2 == 129 * HMiB && (size_t)M * 256 * 2 == 129 * QMiB, "sizes");
static_assert(WS_PR + (size_t)M * RWC * 2 <= WS_KB && WS_BIG + (size_t)M * DFF * 2 <= WS_KB && WS_VR + (size_t)M * DM * 4 <= WS_END && WS_VB + 129 * HMiB <= WS_END, "ws map");
constexpr int LDS_BYTES = 147456;

struct Args { const float* in[30]; float* out; unsigned char* ws; int ph_lo, ph_hi, G, pad; unsigned char seq[64]; };
typedef const __attribute__((address_space(4))) Args ArgsK;

__device__ __forceinline__ float bf2f(unsigned short b) { return __uint_as_float(((unsigned)b) << 16); }
template <int CTRL> __device__ __forceinline__ float dppf(float v) { return __int_as_float(__builtin_amdgcn_update_dpp(0, __float_as_int(v), CTRL, 0xF, 0xF, false)); }
__device__ __forceinline__ float red8(float v) { v += dppf<0xB1>(v); v += dppf<0x4E>(v); v += dppf<0x141>(v); return v; }
__device__ __forceinline__ float wave_sum(float v) {
    v = red8(v); v += dppf<0x140>(v);
    { const auto r = __builtin_amdgcn_permlane16_swap(__float_as_uint(v), __float_as_uint(v), false, false); v = __uint_as_float(r[0]) + __uint_as_float(r[1]); }
    { const auto r = __builtin_amdgcn_permlane32_swap(__float_as_uint(v), __float_as_uint(v), false, false); v = __uint_as_float(r[0]) + __uint_as_float(r[1]); }
    return v;
}
__device__ __forceinline__ float sigmoidf_(float x) { return 1.0f / (1.0f + __expf(-x)); }
#define LDS_WAIT() asm volatile("s_waitcnt lgkmcnt(0)" ::: "memory")

struct EpiLora {
    bf16_t *DEC, *AA, *GG; const float *w0, *a0;
    __device__ __forceinline__ void operator()(const f32x4 (&acc)[2][2][4][2], const pg8::Unit& u, int wr, int wc, int fr, int fq) const {
        const int row0 = u.pm * 256 + wr * 64 + fr, pn = u.pn, cb = (pn & 1) * 256 + wc * 32 + 8 * fq;
        const float* offp = pn < 2 ? w0 : a0; bf16_t* O16 = pn < 2 ? DEC : (pn < 4 ? AA : GG);
#pragma unroll
        for (int ai = 0; ai < 2; ++ai)
#pragma unroll
            for (int m = 0; m < 4; ++m) { const size_t r = (size_t)(row0 + ai * 128 + m * 16);
#pragma unroll
                for (int bj = 0; bj < 2; ++bj) { const int c = cb + bj * 128; f32x4 v0 = acc[ai][bj][m][0], v1 = acc[ai][bj][m][1];
                    if (pn < 4) { v0 = v0 + *(const f32x4*)(offp + c); v1 = v1 + *(const f32x4*)(offp + c + 4);
#pragma unroll
                        for (int j = 0; j < 4; ++j) { v0[j] = __builtin_amdgcn_rcpf(1.0f + __builtin_amdgcn_exp2f(-LOG2E * v0[j])); v1[j] = __builtin_amdgcn_rcpf(1.0f + __builtin_amdgcn_exp2f(-LOG2E * v1[j])); } }
                    { u32x4 w; w.x = cvt_pk_bf16(v0[0], v0[1]); w.y = cvt_pk_bf16(v0[2], v0[3]); w.z = cvt_pk_bf16(v1[0], v1[1]); w.w = cvt_pk_bf16(v1[2], v1[3]); *(u32x4*)(O16 + r * 512 + c) = w; } } }
    }
};
struct EpiF32 {
    static constexpr bool PERM = true, AFTER_DRAIN = false;
    bf16_t* C; int ldc; int mode; EpiLora L;
    __device__ __forceinline__ void operator()(const f32x4 (&acc)[2][2][4][2], const pg8::Unit& u, int wr, int wc, int fr, int fq) const {
        if (mode) { L(acc, u, wr, wc, fr, fq); return; }
        const int row0 = u.pm * 256 + wr * 64 + fr, col0 = u.pn * 256 + wc * 32 + 8 * fq;
#pragma unroll
        for (int ai = 0; ai < 2; ++ai)
#pragma unroll
            for (int m = 0; m < 4; ++m) { bf16_t* rowp = C + (size_t)(row0 + ai * 128 + m * 16) * ldc + col0;
#pragma unroll
                for (int bj = 0; bj < 2; ++bj) { const f32x4 v0 = acc[ai][bj][m][0], v1 = acc[ai][bj][m][1];
                    u32x4 w; w.x = cvt_pk_bf16(v0[0], v0[1]); w.y = cvt_pk_bf16(v0[2], v0[3]); w.z = cvt_pk_bf16(v1[0], v1[1]); w.w = cvt_pk_bf16(v1[2], v1[3]); *(u32x4*)(rowp + bj * 128) = w; } }
    }
};
struct EpiSwiglu {
    static constexpr bool PERM = true, AFTER_DRAIN = false;
    bf16_t* H;
    __device__ __forceinline__ void operator()(const f32x4 (&acc)[2][2][4][2], const pg8::Unit& u, int wr, int wc, int fr, int fq) const {
        const int row0 = u.pm * 256 + wr * 64 + fr, col0 = u.pn * 128 + wc * 32 + 8 * fq;
#pragma unroll
        for (int ai = 0; ai < 2; ++ai)
#pragma unroll
            for (int m = 0; m < 4; ++m) { bf16_t* rowp = H + (size_t)(row0 + ai * 128 + m * 16) * DFF + col0;
                float hv[8];
#pragma unroll
                for (int n = 0; n < 2; ++n)
#pragma unroll
                    for (int j = 0; j < 4; ++j) { const float g = acc[ai][0][m][n][j], up = acc[ai][1][m][n][j];
                        hv[n * 4 + j] = g * __builtin_amdgcn_rcpf(1.0f + __builtin_amdgcn_exp2f(-g * LOG2E)) * up; }
                u32x4 w; w.x = cvt_pk_bf16(hv[0], hv[1]); w.y = cvt_pk_bf16(hv[2], hv[3]); w.z = cvt_pk_bf16(hv[4], hv[5]); w.w = cvt_pk_bf16(hv[6], hv[7]);
                *(u32x4*)rowp = w; }
    }
};
__device__ __forceinline__ float log_sigmoid_(float x) { return fminf(x, 0.f) - log1pf(expf(-fabsf(x))); }
struct EpiProj {
    static constexpr bool PERM = true, AFTER_DRAIN = false;
    bf16_t *QB, *KB, *VB, *PR; float* out; const float* bf;
    __device__ __forceinline__ void operator()(const f32x4 (&acc)[2][2][4][2], const pg8::Unit& u, int wr, int wc, int fr, int fq) const {
        const int row0 = u.pm * 256 + wr * 64 + fr, colt = wc * 32 + 8 * fq, pn = u.pn; const bool smp = u.pm >= 256;
        if (pn < 2) {
#pragma unroll
            for (int ai = 0; ai < 2; ++ai)
#pragma unroll
                for (int m = 0; m < 4; ++m) { bf16_t* rowp = QB + (size_t)(row0 + ai * 128 + m * 16) * 512 + pn * 256 + colt;
#pragma unroll
                    for (int bj = 0; bj < 2; ++bj) { const f32x4 v0 = acc[ai][bj][m][0] * QSCALE, v1 = acc[ai][bj][m][1] * QSCALE;
                        u32x4 w; w.x = cvt_pk_bf16(v0[0], v0[1]); w.y = cvt_pk_bf16(v0[2], v0[3]); w.z = cvt_pk_bf16(v1[0], v1[1]); w.w = cvt_pk_bf16(v1[2], v1[3]); *(u32x4*)(rowp + bj * 128) = w; } }
        } else if (pn < 6) {
            const int which = (pn - 2) >> 1, cb = ((pn - 2) & 1) * 256 + colt;
            bf16_t* B16 = which ? VB : KB;
            float* F32 = out + (smp ? (which ? O_FVS : O_FKS) : (which ? O_FVP : O_FKP));
#pragma unroll
            for (int ai = 0; ai < 2; ++ai)
#pragma unroll
                for (int m = 0; m < 4; ++m) { const int r = row0 + ai * 128 + m * 16; bf16_t* rowp = B16 + (size_t)r * 512 + cb; float* rowf = F32 + (size_t)(smp ? r - MP : r) * 512 + cb;
#pragma unroll
                    for (int bj = 0; bj < 2; ++bj) { const f32x4 v0 = acc[ai][bj][m][0], v1 = acc[ai][bj][m][1]; __builtin_nontemporal_store(v0, (f32x4*)(rowf + bj * 128)); __builtin_nontemporal_store(v1, (f32x4*)(rowf + bj * 128 + 4));
                        u32x4 w; w.x = cvt_pk_bf16(v0[0], v0[1]); w.y = cvt_pk_bf16(v0[2], v0[3]); w.z = cvt_pk_bf16(v1[0], v1[1]); w.w = cvt_pk_bf16(v1[2], v1[3]); *(u32x4*)(rowp + bj * 128) = w; } }
        } else if (pn < 13) {
            const int cb = (pn - 6) * 256 + colt;
#pragma unroll
            for (int ai = 0; ai < 2; ++ai)
#pragma unroll
                for (int m = 0; m < 4; ++m) { const int r = row0 + ai * 128 + m * 16; bf16_t* rowp = PR + (size_t)r * RWC + cb;
                    const bool last = smp ? (((r - MP) & 15) == 15) : ((r & 2047) == 2047);
                    float* rowf = out + (smp ? O_RSHS + (size_t)((r - MP) >> 4) * RWC : O_RSHP + (size_t)(r >> 11) * RWC) + cb;
#pragma unroll
                    for (int bj = 0; bj < 2; ++bj) { const f32x4 v0 = acc[ai][bj][m][0], v1 = acc[ai][bj][m][1]; if (last) { *(f32x4*)(rowf + bj * 128) = v0; *(f32x4*)(rowf + bj * 128 + 4) = v1; }
                        u32x4 w; w.x = cvt_pk_bf16(v0[0], v0[1]); w.y = cvt_pk_bf16(v0[2], v0[3]); w.z = cvt_pk_bf16(v1[0], v1[1]); w.w = cvt_pk_bf16(v1[2], v1[3]); *(u32x4*)(rowp + bj * 128) = w; } }
        } else {
            if (wc == 0 && fq == 0) {
                const f32x4 b0 = *(const f32x4*)bf, b1 = *(const f32x4*)(bf + 4);
#pragma unroll
                for (int ai = 0; ai < 2; ++ai)
#pragma unroll
                    for (int m = 0; m < 4; ++m) { const int r = row0 + ai * 128 + m * 16; const f32x4 v0 = acc[ai][0][m][0] + b0, v1 = acc[ai][0][m][1] + b1;
                        f32x4 l0, l1;
#pragma unroll
                        for (int j = 0; j < 4; ++j) { l0[j] = log_sigmoid_(v0[j]); l1[j] = log_sigmoid_(v1[j]); }
                        float* dst = out + (smp ? O_FLS + (size_t)(r - MP) * 8 : O_FLP + (size_t)r * 8);
                        *(f32x4*)dst = l0; *(f32x4*)(dst + 4) = l1; }
            }
        }
    }
};
struct EpiGelu {
    static constexpr bool PERM = true, AFTER_DRAIN = false;
    bf16_t* U; bf16_t* VR;
    __device__ __forceinline__ void operator()(const f32x4 (&acc)[2][2][4][2], const pg8::Unit& u, int wr, int wc, int fr, int fq) const {
        const int row0 = u.pm * 256 + wr * 64 + fr, pn = u.pn, cb = (pn & 3) * 256 + wc * 32 + 8 * fq;
#pragma unroll
        for (int ai = 0; ai < 2; ++ai)
#pragma unroll
            for (int m = 0; m < 4; ++m) { const size_t r = (size_t)(row0 + ai * 128 + m * 16);
#pragma unroll
                for (int bj = 0; bj < 2; ++bj) { const f32x4 v0 = acc[ai][bj][m][0], v1 = acc[ai][bj][m][1];
                    const f32x2 g0 = pg8::gelu_pk((f32x2){v0[0], v0[1]}), g1 = pg8::gelu_pk((f32x2){v0[2], v0[3]}), g2 = pg8::gelu_pk((f32x2){v1[0], v1[1]}), g3 = pg8::gelu_pk((f32x2){v1[2], v1[3]});
                    const int c = cb + bj * 128;
                    u32x4 w; w.x = cvt_pk_bf16(g0.x, g0.y); w.y = cvt_pk_bf16(g1.x, g1.y); w.z = cvt_pk_bf16(g2.x, g2.y); w.w = cvt_pk_bf16(g3.x, g3.y);
                    *(u32x4*)((pn < 4 ? U : VR) + r * DM + c) = w; } }
    }
};
struct SrcIdent { __device__ __forceinline__ int operator()(int c) const { return c; } };
struct SrcFfnIn { __device__ __forceinline__ int operator()(int c) const { return ((c >> 7) & 1) * DFF + (c >> 8) * 128 + (c & 127); } };
struct SrcEvenIn { __device__ __forceinline__ int operator()(int c) const { return c < 1536 ? c : (c < 3328 ? c + 8 : (c < 3336 ? c - 3328 + 1536 : -1)); } };
template <class Src> __device__ __forceinline__ void transpose_job(const float* W, int K, int ldw, bf16_t* WT, int Nout, const Src src, LAS float* scr, int gw, int NGW, int lane) {
    const int nblk = Nout / 32, nitems = (K / 64) * nblk;
    for (int it = gw; it < nitems; it += NGW) {
        const int kb = it / nblk, nb = it % nblk, k0 = 64 * kb, n0 = 32 * nb; const int sc = src(n0 + (lane & 31));
        float wv[32];
#pragma unroll
        for (int i = 0; i < 32; ++i) { const int kk = 2 * i + (lane >> 5); wv[i] = sc >= 0 ? __builtin_nontemporal_load(W + (size_t)(k0 + kk) * ldw + sc) : 0.f; }
#pragma unroll
        for (int i = 0; i < 32; ++i) { const int kk = 2 * i + (lane >> 5); scr[kk * 33 + (lane & 31)] = wv[i]; }
        LDS_WAIT();
        const int c = lane & 7;
#pragma unroll
        for (int j = 0; j < 4; ++j) { const int n = (lane >> 3) + 8 * j; const LAS float* s = scr + (8 * c) * 33 + n;
            u32x4 o; o.x = cvt_pk_bf16(s[0 * 33], s[1 * 33]); o.y = cvt_pk_bf16(s[2 * 33], s[3 * 33]); o.z = cvt_pk_bf16(s[4 * 33], s[5 * 33]); o.w = cvt_pk_bf16(s[6 * 33], s[7 * 33]);
            *(u32x4*)(WT + (size_t)(n0 + n) * K + k0 + 8 * c) = o; }
        LDS_WAIT();
    }
}
struct RowRegs { f32x4 v[4]; u32x4 y[2]; };
__device__ __forceinline__ void rn_load(RowRegs& R, const float* base, const bf16_t* y, int lane) {
#pragma unroll
    for (int j = 0; j < 2; ++j) { R.v[2 * j] = __builtin_nontemporal_load((const f32x4*)(base + 512 * j + 8 * lane)); R.v[2 * j + 1] = __builtin_nontemporal_load((const f32x4*)(base + 512 * j + 8 * lane + 4)); if (y) R.y[j] = __builtin_nontemporal_load((const u32x4*)(y + 512 * j + 8 * lane)); }
}
__device__ __forceinline__ void rn_finish(RowRegs& R, bool hasy, const float* gpost, float scale, float* xo, const float* gpre, bf16_t* hn, int lane) {
    if (hasy) { f32x4 t[4]; float s = 0.f;
#pragma unroll
        for (int j = 0; j < 2; ++j) { const u32x4 w = R.y[j];
            t[2 * j] = (f32x4){bf2f(w.x & 0xffff), bf2f(w.x >> 16), bf2f(w.y & 0xffff), bf2f(w.y >> 16)}; t[2 * j + 1] = (f32x4){bf2f(w.z & 0xffff), bf2f(w.z >> 16), bf2f(w.w & 0xffff), bf2f(w.w >> 16)}; }
#pragma unroll
        for (int j = 0; j < 4; ++j) s += (t[j][0] * t[j][0] + t[j][1] * t[j][1]) + (t[j][2] * t[j][2] + t[j][3] * t[j][3]);
        const float rs = rsqrtf(wave_sum(s) * (1.f / DM) + 1e-6f) * scale;
#pragma unroll
        for (int j = 0; j < 4; ++j) { const f32x4 g = *(const f32x4*)(gpost + 512 * (j >> 1) + 8 * lane + 4 * (j & 1)); R.v[j] = R.v[j] + t[j] * g * rs; } }
    if (xo) {
#pragma unroll
        for (int j = 0; j < 4; ++j) __builtin_nontemporal_store(R.v[j], (f32x4*)(xo + 512 * (j >> 1) + 8 * lane + 4 * (j & 1))); }
    if (hn) { float s = 0.f;
#pragma unroll
        for (int j = 0; j < 4; ++j) s += (R.v[j][0] * R.v[j][0] + R.v[j][1] * R.v[j][1]) + (R.v[j][2] * R.v[j][2] + R.v[j][3] * R.v[j][3]);
        const float rs = rsqrtf(wave_sum(s) * (1.f / DM) + 1e-6f);
#pragma unroll
        for (int j = 0; j < 2; ++j) { const f32x4 g0 = *(const f32x4*)(gpre + 512 * j + 8 * lane), g1 = *(const f32x4*)(gpre + 512 * j + 8 * lane + 4); const f32x4 o0 = R.v[2 * j] * g0 * rs, o1 = R.v[2 * j + 1] * g1 * rs;
            u32x4 w; w.x = cvt_pk_bf16(o0[0], o0[1]); w.y = cvt_pk_bf16(o0[2], o0[3]); w.z = cvt_pk_bf16(o1[0], o1[1]); w.w = cvt_pk_bf16(o1[2], o1[3]); *(u32x4*)(hn + 512 * j + 8 * lane) = w; } }
}
__device__ __forceinline__ void phase_prologue(ArgsK& a, LAS unsigned char* lds, int gw, int NGW, int wave, int lane) {
    unsigned char* ws = a.ws;
    LAS float* scr = (LAS float*)(lds + wave * 8448);
    for (int i = 0; i < 4; ++i) transpose_job(a.in[8] + (size_t)i * DM * 2 * DFF, DM, 2 * DFF, (bf16_t*)(ws + WS_WFI) + (size_t)i * 2 * DFF * DM, 2 * DFF, SrcFfnIn(), scr, gw, NGW, lane);
    for (int i = 0; i < 4; ++i) transpose_job(a.in[9] + (size_t)i * DFF * DM, DFF, DM, (bf16_t*)(ws + WS_WFO) + (size_t)i * DM * DFF, DM, SrcIdent(), scr, gw, NGW, lane);
    transpose_job(a.in[10], DM, 3336, (bf16_t*)(ws + WS_WEI), NEI, SrcEvenIn(), scr, gw, NGW, lane);
    transpose_job(a.in[23], DM, DM, (bf16_t*)(ws + WS_WEO), DM, SrcIdent(), scr, gw, NGW, lane);
    transpose_job(a.in[24], DM, 2 * DM, (bf16_t*)(ws + WS_WGI), 2 * DM, SrcIdent(), scr, gw, NGW, lane);
    transpose_job(a.in[29], DM, DM, (bf16_t*)(ws + WS_WGO), DM, SrcIdent(), scr, gw, NGW, lane);
    const int gt = gw * 64 + lane, NGT = NGW * 64;
    { bf16_t* WL = (bf16_t*)(ws + WS_WLO);
      for (int i = gt; i < 1536 * 256; i += NGT) { const int n = i >> 8, k = i & 255; float v = 0.f;
          if (n < 512) { if (k < 64) v = a.in[14][k * 512 + n]; } else if (n < 1024) { if (k >= 64 && k < 128) v = a.in[16][(k - 64) * 512 + n - 512]; } else { if (k >= 128) v = a.in[17][(k - 128) * 512 + n - 1024]; }
          WL[i] = (bf16_t)(cvt_pk_bf16(v, 0.f) & 0xffffu); } }
    { bf16_t* WS_ = (bf16_t*)(ws + WS_WSM);
      for (int i = gt; i < 8 * 128 * 128; i += NGT) { const int t = (i >> 7) & 127, s = i & 127; const float v = ((s >> 6) <= (t >> 6)) ? a.in[27][i] : 0.f; WS_[i] = (bf16_t)(cvt_pk_bf16(v, 0.f) & 0xffffu); } }
    for (int m = gw; m < M; m += 2 * NGW) { const int m2 = m + NGW; const bool two = m2 < M;
        const float* x0 = m < MP ? a.in[0] + (size_t)m * DM : a.in[1] + (size_t)(m - MP) * DM; const float* x1 = m2 < MP ? a.in[0] + (size_t)m2 * DM : a.in[1] + (size_t)(m2 - MP) * DM;
        RowRegs R0, R1; rn_load(R0, x0, nullptr, lane); if (two) rn_load(R1, x1, nullptr, lane);
        rn_finish(R0, false, nullptr, 0.f, nullptr, a.in[7], (bf16_t*)(ws + WS_HN) + (size_t)m * DM, lane);
        if (two) rn_finish(R1, false, nullptr, 0.f, nullptr, a.in[7], (bf16_t*)(ws + WS_HN) + (size_t)m2 * DM, lane); }
}
__device__ __forceinline__ void phase_rownorm(ArgsK& a, int idx, int bid, int G, int tid, int wave, int lane, unsigned* cnt) {
    const int layer = idx / 3, k = idx % 3; const float* ng = a.in[7] + (size_t)layer * 6 * DM;
    const float* gpost = ng + (2 * k + 1) * DM; const float scale = (k == 1) ? 1.0f : 0.5f;
    const float* gpre = (k < 2) ? ng + (2 * k + 2) * DM : (layer == 0 ? a.in[7] + 6 * DM : nullptr);
    float* X = a.out; const bf16_t* Y = (const bf16_t*)(a.ws + WS_Y); bf16_t* HN = (bf16_t*)(a.ws + WS_HN);
    if (bid < N_TAIL) return;
    const int gw = (bid - N_TAIL) * 8 + wave, NGW = (G - N_TAIL) * 8;
    for (int m = gw; m < MP; m += 2 * NGW) {
        const int m2 = m + NGW; const bool two = m2 < MP;
        const float* b0 = (idx == 0) ? a.in[0] + (size_t)m * DM : X + (size_t)m * DM;
        const float* b1 = (idx == 0) ? a.in[0] + (size_t)m2 * DM : X + (size_t)m2 * DM;
        RowRegs R0, R1; rn_load(R0, b0, Y + (size_t)m * DM, lane); if (two) rn_load(R1, b1, Y + (size_t)m2 * DM, lane);
        rn_finish(R0, true, gpost, scale, X + (size_t)m * DM, gpre, gpre ? HN + (size_t)m * DM : nullptr, lane);
        if (two) rn_finish(R1, true, gpost, scale, X + (size_t)m2 * DM, gpre, gpre ? HN + (size_t)m2 * DM : nullptr, lane); }
    if (bid < N_TAIL + 32) {
        if (tid == 0) { unsigned sp = 0u; while (__hip_atomic_load(cnt, __ATOMIC_RELAXED, __HIP_MEMORY_SCOPE_AGENT) < (unsigned)N_TAIL && ++sp < (1u << 22)) __builtin_amdgcn_s_sleep(2);
            __builtin_amdgcn_fence(__ATOMIC_ACQUIRE, "agent"); asm volatile("s_waitcnt vmcnt(0)" ::: "memory"); }
        __syncthreads();
        const int m = MP + (bid - N_TAIL) * 16 + wave * 2, m2 = m + 1;
        const float* b0 = (idx == 0) ? a.in[1] + (size_t)(m - MP) * DM : X + (size_t)m * DM;
        const float* b1 = (idx == 0) ? a.in[1] + (size_t)(m2 - MP) * DM : X + (size_t)m2 * DM;
        RowRegs R0, R1; rn_load(R0, b0, Y + (size_t)m * DM, lane); rn_load(R1, b1, Y + (size_t)m2 * DM, lane);
        rn_finish(R0, true, gpost, scale, X + (size_t)m * DM, gpre, gpre ? HN + (size_t)m * DM : nullptr, lane);
        rn_finish(R1, true, gpost, scale, X + (size_t)m2 * DM, gpre, gpre ? HN + (size_t)m2 * DM : nullptr, lane); }
}
struct TailOrder : pg8::StaticOrder {
    int tmode, tbid;
    __device__ __forceinline__ bool next(int i, pg8::Unit& u) const {
        if (tmode == 0) return pg8::StaticOrder::next(i, u);
        if (i > 0 || tbid >= N_TAIL) return false;
        u.pm = 256 + (tbid >> 2); u.pn = tbid & 3; return true; }
};
__device__ __forceinline__ void phase_prep(ArgsK& a, int gw, int NGW, int lane) {
    const bf16_t* PR = (const bf16_t*)(a.ws + WS_PR); bf16_t* LA = (bf16_t*)(a.ws + WS_LA);
    const f32x4 mu = *(const f32x4*)(a.in[12] + 1536 + 4 * lane);
    for (int m0 = gw; m0 < M; m0 += 4 * NGW) {
        u32x2 cw[4], pw[4]; f32x4 pf[4]; int tt[4];
#pragma unroll
        for (int q = 0; q < 4; ++q) { const int m = m0 + q * NGW; cw[q] = (u32x2){0u, 0u}; pw[q] = (u32x2){0u, 0u}; pf[q] = (f32x4){0.f, 0.f, 0.f, 0.f}; tt[q] = -1;
            if (m < M) { const bool smp = m >= MP; const int t = smp ? ((m - MP) & 15) : (m & 2047); tt[q] = t;
                cw[q] = *(const u32x2*)(PR + (size_t)m * RWC + 1536 + 4 * lane);
                if (t > 0) pw[q] = *(const u32x2*)(PR + (size_t)(m - 1) * RWC + 1536 + 4 * lane);
                else if (smp) pf[q] = *(const f32x4*)(a.in[6] + (size_t)((m - MP) >> 4) * RWC + 1536 + 4 * lane); } }
#pragma unroll
        for (int q = 0; q < 4; ++q) { const int m = m0 + q * NGW; if (m < M) {
            const f32x4 cur = (f32x4){bf2f(cw[q].x & 0xffff), bf2f(cw[q].x >> 16), bf2f(cw[q].y & 0xffff), bf2f(cw[q].y >> 16)};
            const f32x4 prev = (tt[q] > 0) ? (f32x4){bf2f(pw[q].x & 0xffff), bf2f(pw[q].x >> 16), bf2f(pw[q].y & 0xffff), bf2f(pw[q].y >> 16)} : pf[q];
            f32x4 xm = cur + (prev - cur) * mu;
            if (lane < 16) {
#pragma unroll
                for (int j = 0; j < 4; ++j) xm[j] = tanhf(xm[j]); }
            else if (lane >= 32) {
#pragma unroll
                for (int j = 0; j < 4; ++j) xm[j] = sigmoidf_(xm[j]); }
            u32x2 w; w.x = cvt_pk_bf16(xm[0], xm[1]); w.y = cvt_pk_bf16(xm[2], xm[3]); *(u32x2*)(LA + (size_t)m * 256 + 4 * lane) = w; } }
    }
    for (int sq = gw; sq < 512; sq += NGW) {
        const bool smp = sq >= 256; const int bh = sq & 255, b = bh >> 3, h = bh & 7;
        const float* src = smp ? a.in[4] + ((size_t)b * PASTL) * 8 + h : a.out + O_FLP + ((size_t)b * SEQ) * 8 + h;
        float* dst = smp ? (float*)(a.ws + WS_CUMS) + ((size_t)b * CTOT) * 8 + h : (float*)(a.ws + WS_CUMP) + ((size_t)b * SEQ) * 8 + h;
        float tot = 0.f;
        for (int i = 0; i < 32; ++i) tot += src[(size_t)(lane * 32 + i) * 8];
        float inc = tot;
#pragma unroll
        for (int o = 1; o < 64; o <<= 1) { const float nb = __shfl_up(inc, o); if (lane >= o) inc += nb; }
        float run = inc - tot;
        for (int i = 0; i < 32; ++i) { run += src[(size_t)(lane * 32 + i) * 8]; dst[(size_t)(lane * 32 + i) * 8] = run; }
        if (smp) { float endv = __shfl(inc, 63);
            if (lane == 0) { const float* nsrc = a.out + O_FLS + ((size_t)b * DSEQ) * 8 + h;
                for (int i = 0; i < DSEQ; ++i) { endv += nsrc[i * 8]; dst[(size_t)(PASTL + i) * 8] = endv; } } }
    }
}
struct ScanRaw { u32x4 cr, ck, cv, pr, pk, pv, aa, dd; };
__device__ __forceinline__ void unpack8(const u32x4& w, f32x4& lo, f32x4& hi) {
    lo = (f32x4){__uint_as_float(w.x << 16), __uint_as_float(w.x & 0xffff0000u), __uint_as_float(w.y << 16), __uint_as_float(w.y & 0xffff0000u)};
    hi = (f32x4){__uint_as_float(w.z << 16), __uint_as_float(w.z & 0xffff0000u), __uint_as_float(w.w << 16), __uint_as_float(w.w & 0xffff0000u)};
}
__device__ __forceinline__ u32x4 pack8u(const f32x4& lo, const f32x4& hi) { u32x4 w; w.x = cvt_pk_bf16(lo[0], lo[1]); w.y = cvt_pk_bf16(lo[2], lo[3]); w.z = cvt_pk_bf16(hi[0], hi[1]); w.w = cvt_pk_bf16(hi[2], hi[3]); return w; }
struct ScanOps { f32x4 a0, a1, w0, w1, b0, b1, k0, k1, r0, r1; float vi; };
#define F2LO(v) ((f32x2){(v)[0], (v)[1]})
#define F2HI(v) ((f32x2){(v)[2], (v)[3]})
constexpr int SC_T = 32, SC_ARR = SC_T * 64, SC_SET = 7 * SC_ARR;
__device__ __forceinline__ void scan_unit(ArgsK& a, LAS unsigned char* lds, int u, int tid, int wave, int lane) {
    const bool smp = u >= 256; const int bh = u & 255, b = bh >> 3, h = bh & 7;
    const int T = smp ? DSEQ : SEQ; const size_t row0 = smp ? (size_t)MP + b * DSEQ : (size_t)b * SEQ;
    const int NC = (T + SC_T - 1) / SC_T;
    LAS float* L0 = (LAS float*)lds;
    const bf16_t* PR = (const bf16_t*)(a.ws + WS_PR); const bf16_t* AA = (const bf16_t*)(a.ws + WS_AA); const bf16_t* GG = (const bf16_t*)(a.ws + WS_GG); const bf16_t* DEC = (const bf16_t*)(a.ws + WS_DEC);
    bf16_t* MIX = (bf16_t*)(a.ws + WS_MIX);
    const bool scanw = wave < 4;
    const int si = (wave & 3) * 8 + (lane >> 3), c8 = (lane & 7) * 8, hc = h * 64 + c8;
    f32x2 sA[4], sB[4];
    if (smp && scanw) { const float* sp = a.in[5] + (((size_t)bh * 64) + 2 * si) * 64 + c8; const f32x4 x0 = *(const f32x4*)sp, x1 = *(const f32x4*)(sp + 4), y0 = *(const f32x4*)(sp + 64), y1 = *(const f32x4*)(sp + 68);
        sA[0] = F2LO(x0); sA[1] = F2HI(x0); sA[2] = F2LO(x1); sA[3] = F2HI(x1); sB[0] = F2LO(y0); sB[1] = F2HI(y0); sB[2] = F2LO(y1); sB[3] = F2HI(y1); }
    else {
#pragma unroll
        for (int j = 0; j < 4; ++j) { sA[j] = (f32x2){0.f, 0.f}; sB[j] = (f32x2){0.f, 0.f}; } }
    ScanRaw raw; u32x4 ggw = (u32x4){0u, 0u, 0u, 0u};
#define SCAN_LOAD_RAW(t0_) do { const int t_ = (t0_) + si; const u32x4 z_ = (u32x4){0u, 0u, 0u, 0u}; \
        raw.cr = raw.ck = raw.cv = raw.pr = raw.pk = raw.pv = raw.aa = raw.dd = z_; \
        if (t_ < T) { const size_t m_ = row0 + t_; const bf16_t* p_ = PR + m_ * RWC + hc; \
            raw.cr = *(const u32x4*)p_; raw.ck = *(const u32x4*)(p_ + 512); raw.cv = *(const u32x4*)(p_ + 1024); \
            if (t_ > 0) { raw.pr = *(const u32x4*)(p_ - RWC); raw.pk = *(const u32x4*)(p_ - RWC + 512); raw.pv = *(const u32x4*)(p_ - RWC + 1024); } \
            else if (smp) { const float* sh_ = a.in[6] + (size_t)b * RWC + hc; raw.pr = pack8u(*(const f32x4*)sh_, *(const f32x4*)(sh_ + 4)); raw.pk = pack8u(*(const f32x4*)(sh_ + 512), *(const f32x4*)(sh_ + 516)); raw.pv = pack8u(*(const f32x4*)(sh_ + 1024), *(const f32x4*)(sh_ + 1028)); } \
            raw.aa = *(const u32x4*)(AA + m_ * 512 + hc); raw.dd = *(const u32x4*)(DEC + m_ * 512 + hc); } } while (0)
#define SCAN_PREP(S_) do { LAS float* B_ = L0 + (S_) * SC_SET; \
            f32x4 cl, ch, pl, ph, r0, r1, k0, k1, v0, v1, al, ah; \
            const f32x4 mr0 = *(const f32x4*)(a.in[12] + hc), mr1 = *(const f32x4*)(a.in[12] + hc + 4), mk0 = *(const f32x4*)(a.in[12] + 512 + hc), mk1 = *(const f32x4*)(a.in[12] + 512 + hc + 4), mv0 = *(const f32x4*)(a.in[12] + 1024 + hc), mv1 = *(const f32x4*)(a.in[12] + 1024 + hc + 4); \
            unpack8(raw.cr, cl, ch); unpack8(raw.pr, pl, ph); r0 = cl + (pl - cl) * mr0; r1 = ch + (ph - ch) * mr1; \
            unpack8(raw.ck, cl, ch); unpack8(raw.pk, pl, ph); k0 = cl + (pl - cl) * mk0; k1 = ch + (ph - ch) * mk1; \
            unpack8(raw.cv, cl, ch); unpack8(raw.pv, pl, ph); v0 = cl + (pl - cl) * mv0; v1 = ch + (ph - ch) * mv1; \
            unpack8(raw.aa, al, ah); \
            const f32x4 kw0 = *(const f32x4*)(a.in[18] + hc), kw1 = *(const f32x4*)(a.in[18] + hc + 4), ka0 = *(const f32x4*)(a.in[19] + hc), ka1 = *(const f32x4*)(a.in[19] + hc + 4); \
            f32x4 q0 = k0 * kw0, q1 = k1 * kw1; \
            const float n2 = red8((q0[0] * q0[0] + q0[1] * q0[1]) + (q0[2] * q0[2] + q0[3] * q0[3]) + ((q1[0] * q1[0] + q1[1] * q1[1]) + (q1[2] * q1[2] + q1[3] * q1[3]))); \
            const float inv = 1.0f / fmaxf(sqrtf(n2), 1e-12f); \
            q0 = q0 * inv; q1 = q1 * inv; \
            const f32x4 km0 = k0 * (1.0f + (al - 1.0f) * ka0), km1 = k1 * (1.0f + (ah - 1.0f) * ka1); \
            const int o = si * 64 + c8; \
            *(LAS f32x4*)(B_ + o) = r0; *(LAS f32x4*)(B_ + o + 4) = r1; { f32x4 dl_, dh_; unpack8(raw.dd, dl_, dh_); \
              _Pragma("unroll") for (int j_ = 0; j_ < 4; ++j_) { dl_[j_] = __builtin_amdgcn_exp2f(-0.6065306597f * LOG2E * dl_[j_]); dh_[j_] = __builtin_amdgcn_exp2f(-0.6065306597f * LOG2E * dh_[j_]); } \
              *(LAS f32x4*)(B_ + SC_ARR + o) = dl_; *(LAS f32x4*)(B_ + SC_ARR + o + 4) = dh_; } \
            *(LAS f32x4*)(B_ + 2 * SC_ARR + o) = km0; *(LAS f32x4*)(B_ + 2 * SC_ARR + o + 4) = km1; *(LAS f32x4*)(B_ + 3 * SC_ARR + o) = v0; *(LAS f32x4*)(B_ + 3 * SC_ARR + o + 4) = v1; \
            *(LAS f32x4*)(B_ + 4 * SC_ARR + o) = -q0; *(LAS f32x4*)(B_ + 4 * SC_ARR + o + 4) = -q1; *(LAS f32x4*)(B_ + 5 * SC_ARR + o) = q0 * al; *(LAS f32x4*)(B_ + 5 * SC_ARR + o + 4) = q1 * ah; } while (0)
#define SCAN_POST(S_, t0_) do { if ((t0_) + si < T) { const LAS float* B_ = L0 + (S_) * SC_SET; const int o = si * 64 + c8; const size_t m = row0 + (t0_) + si; \
            const f32x4 y0 = *(const LAS f32x4*)(B_ + 6 * SC_ARR + o), y1 = *(const LAS f32x4*)(B_ + 6 * SC_ARR + o + 4); \
            const float mean = red8((y0[0] + y0[1]) + (y0[2] + y0[3]) + ((y1[0] + y1[1]) + (y1[2] + y1[3]))) * (1.f / 64.f); \
            const f32x4 d0 = y0 - mean, d1 = y1 - mean; \
            const float var = red8((d0[0] * d0[0] + d0[1] * d0[1]) + (d0[2] * d0[2] + d0[3] * d0[3]) + ((d1[0] * d1[0] + d1[1] * d1[1]) + (d1[2] * d1[2] + d1[3] * d1[3]))) * (1.f / 64.f); \
            const float rstd = rsqrtf(var + 64e-5f); \
            const f32x4 r0 = *(const LAS f32x4*)(B_ + o), r1 = *(const LAS f32x4*)(B_ + o + 4), k0 = *(const LAS f32x4*)(B_ + 2 * SC_ARR + o), k1 = *(const LAS f32x4*)(B_ + 2 * SC_ARR + o + 4), v0 = *(const LAS f32x4*)(B_ + 3 * SC_ARR + o), v1 = *(const LAS f32x4*)(B_ + 3 * SC_ARR + o + 4); \
            const f32x4 rk0 = *(const f32x4*)(a.in[20] + hc), rk1 = *(const f32x4*)(a.in[20] + hc + 4); \
            const f32x4 e0 = r0 * k0 * rk0, e1 = r1 * k1 * rk1; \
            const float bon = red8((e0[0] + e0[1]) + (e0[2] + e0[3]) + ((e1[0] + e1[1]) + (e1[2] + e1[3]))); \
            f32x4 gl, gh; unpack8(ggw, gl, gh); \
            const f32x4 o0 = (d0 * rstd * *(const f32x4*)(a.in[21] + hc) + *(const f32x4*)(a.in[22] + hc) + v0 * bon) * gl; \
            const f32x4 o1 = (d1 * rstd * *(const f32x4*)(a.in[21] + hc + 4) + *(const f32x4*)(a.in[22] + hc + 4) + v1 * bon) * gh; \
            *(u32x4*)(MIX + m * DM + 512 + hc) = pack8u(o0, o1); } } while (0)
#define SCAN_LD(O, V2, B_, tt_) do { const int o_ = (tt_) * 64 + c8; O.a0 = *(const LAS f32x4*)(B_ + 4 * SC_ARR + o_); O.a1 = *(const LAS f32x4*)(B_ + 4 * SC_ARR + o_ + 4); O.w0 = *(const LAS f32x4*)(B_ + SC_ARR + o_); O.w1 = *(const LAS f32x4*)(B_ + SC_ARR + o_ + 4); \
                O.b0 = *(const LAS f32x4*)(B_ + 5 * SC_ARR + o_); O.b1 = *(const LAS f32x4*)(B_ + 5 * SC_ARR + o_ + 4); O.k0 = *(const LAS f32x4*)(B_ + 2 * SC_ARR + o_); O.k1 = *(const LAS f32x4*)(B_ + 2 * SC_ARR + o_ + 4); \
                O.r0 = *(const LAS f32x4*)(B_ + o_); O.r1 = *(const LAS f32x4*)(B_ + o_ + 4); V2 = *(const LAS f32x2*)(B_ + 3 * SC_ARR + (tt_) * 64 + 2 * si); } while (0)
#define SCAN_STEP(O, V2, B_, tt_) do { \
                const f32x2 a01 = F2LO(O.a0), a23 = F2HI(O.a0), a45 = F2LO(O.a1), a67 = F2HI(O.a1); \
                f32x2 pA = sA[0] * a01, pB = sB[0] * a01; pA = sA[1] * a23 + pA; pB = sB[1] * a23 + pB; pA = sA[2] * a45 + pA; pB = sB[2] * a45 + pB; pA = sA[3] * a67 + pA; pB = sB[3] * a67 + pB; \
                float saA = pA[0] + pA[1], saB = pB[0] + pB[1]; \
                saA += dppf<0xB1>(saA); saB += dppf<0xB1>(saB); saA += dppf<0x4E>(saA); saB += dppf<0x4E>(saB); saA += dppf<0x141>(saA); saB += dppf<0x141>(saB); \
                const f32x2 svA = (f32x2){saA, saA}, svB = (f32x2){saB, saB}, vvA = (f32x2){V2[0], V2[0]}, vvB = (f32x2){V2[1], V2[1]}; \
                { const f32x2 w = F2LO(O.w0), bb = F2LO(O.b0), kk = F2LO(O.k0); sA[0] = sA[0] * w + (svA * bb + vvA * kk); sB[0] = sB[0] * w + (svB * bb + vvB * kk); } \
                { const f32x2 w = F2HI(O.w0), bb = F2HI(O.b0), kk = F2HI(O.k0); sA[1] = sA[1] * w + (svA * bb + vvA * kk); sB[1] = sB[1] * w + (svB * bb + vvB * kk); } \
                { const f32x2 w = F2LO(O.w1), bb = F2LO(O.b1), kk = F2LO(O.k1); sA[2] = sA[2] * w + (svA * bb + vvA * kk); sB[2] = sB[2] * w + (svB * bb + vvB * kk); } \
                { const f32x2 w = F2HI(O.w1), bb = F2HI(O.b1), kk = F2HI(O.k1); sA[3] = sA[3] * w + (svA * bb + vvA * kk); sB[3] = sB[3] * w + (svB * bb + vvB * kk); } \
                const f32x2 r01 = F2LO(O.r0), r23 = F2HI(O.r0), r45 = F2LO(O.r1), r67 = F2HI(O.r1); \
                f32x2 qA = sA[0] * r01, qB = sB[0] * r01; qA = sA[1] * r23 + qA; qB = sB[1] * r23 + qB; qA = sA[2] * r45 + qA; qB = sB[2] * r45 + qB; qA = sA[3] * r67 + qA; qB = sB[3] * r67 + qB; \
                float yA = qA[0] + qA[1], yB = qB[0] + qB[1]; \
                yA += dppf<0xB1>(yA); yB += dppf<0xB1>(yB); yA += dppf<0x4E>(yA); yB += dppf<0x4E>(yB); yA += dppf<0x141>(yA); yB += dppf<0x141>(yB); \
                if ((lane & 7) == 0) *(LAS f32x2*)(B_ + 6 * SC_ARR + (tt_) * 64 + 2 * si) = (f32x2){yA, yB}; } while (0)
    if (!scanw) { SCAN_LOAD_RAW(0); SCAN_PREP(0); if (SC_T < T) SCAN_LOAD_RAW(SC_T); }
    __syncthreads();
    for (int c = 0; c < NC; ++c) {
        const int t0 = c * SC_T, nt = (T - t0) < SC_T ? (T - t0) : SC_T;
        if (scanw) {
            LAS float* Bc = L0 + (c & 1) * SC_SET;
            ScanOps oA, oB; f32x2 vA2, vB2;
            SCAN_LD(oA, vA2, Bc, 0);
            for (int tt = 0; tt < nt; tt += 2) {
                SCAN_LD(oB, vB2, Bc, tt + 1);
                SCAN_STEP(oA, vA2, Bc, tt);
                { const int tn = (tt + 2 < nt) ? tt + 2 : tt; SCAN_LD(oA, vA2, Bc, tn); }
                SCAN_STEP(oB, vB2, Bc, tt + 1);
            }
        } else {
            if (c >= 1) SCAN_POST((c - 1) & 1, t0 - SC_T);
            if (t0 + si < T) ggw = *(const u32x4*)(GG + (row0 + t0 + si) * 512 + hc);
            if (c + 1 < NC) { SCAN_PREP((c + 1) & 1); if (t0 + 2 * SC_T < T) SCAN_LOAD_RAW(t0 + 2 * SC_T); }
        }
        __syncthreads();
    }
    if (!scanw) SCAN_POST((NC - 1) & 1, (NC - 1) * SC_T);
    __syncthreads();
#undef SCAN_LOAD_RAW
#undef SCAN_PREP
#undef SCAN_POST
#undef SCAN_LD
#undef SCAN_STEP
    if (scanw) { float* so = a.out + (smp ? O_RSS : O_RSP) + (((size_t)bh * 64) + 2 * si) * 64 + c8;
      *(f32x4*)so = (f32x4){sA[0][0], sA[0][1], sA[1][0], sA[1][1]}; *(f32x4*)(so + 4) = (f32x4){sA[2][0], sA[2][1], sA[3][0], sA[3][1]};
      *(f32x4*)(so + 64) = (f32x4){sB[0][0], sB[0][1], sB[1][0], sB[1][1]}; *(f32x4*)(so + 68) = (f32x4){sB[2][0], sB[2][1], sB[3][0], sB[3][1]}; }
}
#define MFMA16(a_, b_, c_) __builtin_amdgcn_mfma_f32_16x16x32_bf16((a_), (b_), (c_), 0, 0, 0)
__device__ __forceinline__ s16x4 tr_read(LAS unsigned char* p) { return __builtin_bit_cast(s16x4, __builtin_amdgcn_ds_read_tr16_b64_v4i16((LAS v4i16_t*)p)); }
__device__ __forceinline__ bf16x8 pack8(const f32x4& lo, const f32x4& hi) { u32x4 w; w.x = cvt_pk_bf16(lo[0], lo[1]); w.y = cvt_pk_bf16(lo[2], lo[3]); w.z = cvt_pk_bf16(hi[0], hi[1]); w.w = cvt_pk_bf16(hi[2], hi[3]); return __builtin_bit_cast(bf16x8, w); }
constexpr int AT_K = 0, AT_V = 9216, AT_CK = 9216 + 10240, AT_BUF = 19712;
__device__ __forceinline__ float xmax16_32(float v) {
    { const auto r = __builtin_amdgcn_permlane16_swap(__float_as_uint(v), __float_as_uint(v), false, false); v = fmaxf(__uint_as_float(r[0]), __uint_as_float(r[1])); }
    { const auto r = __builtin_amdgcn_permlane32_swap(__float_as_uint(v), __float_as_uint(v), false, false); v = fmaxf(__uint_as_float(r[0]), __uint_as_float(r[1])); }
    return v;
}
__device__ __forceinline__ float xsum16_32(float v) {
    { const auto r = __builtin_amdgcn_permlane16_swap(__float_as_uint(v), __float_as_uint(v), false, false); v = __uint_as_float(r[0]) + __uint_as_float(r[1]); }
    { const auto r = __builtin_amdgcn_permlane32_swap(__float_as_uint(v), __float_as_uint(v), false, false); v = __uint_as_float(r[0]) + __uint_as_float(r[1]); }
    return v;
}
__device__ __forceinline__ void attn_prompt_unit(ArgsK& a, LAS unsigned char* lds, int b, int h, int qb, int tid, int wave, int lane) {
    const int l15 = lane & 15, quad = lane >> 4;
    const bf16_t* QB = (const bf16_t*)(a.ws + WS_QB); const bf16_t* KB = (const bf16_t*)(a.ws + WS_KB); const bf16_t* VB = (const bf16_t*)(a.ws + WS_VB);
    const float* CUM = (const float*)(a.ws + WS_CUMP); bf16_t* MIX = (bf16_t*)(a.ws + WS_MIX);
    const size_t rowb = (size_t)b * SEQ; const int q0 = qb * 256, qw = q0 + wave * 32;
    bf16x8 qf[2][2]; float cq[2];
#pragma unroll
    for (int qq = 0; qq < 2; ++qq) { const size_t r = rowb + qw + qq * 16 + l15; cq[qq] = CUM[r * 8 + h] * LOG2E;
#pragma unroll
        for (int ks = 0; ks < 2; ++ks) qf[qq][ks] = *(const bf16x8*)(QB + r * 512 + h * 64 + ks * 32 + quad * 8); }
    f32x4 o[2][4]; float mrun[2], lrun[2];
#pragma unroll
    for (int qq = 0; qq < 2; ++qq) { mrun[qq] = -INFINITY; lrun[qq] = 0.f;
#pragma unroll
        for (int d = 0; d < 4; ++d) o[qq][d] = (f32x4){0.f, 0.f, 0.f, 0.f}; }
    const int NT = (q0 + 256) / 64, skey = tid >> 3, sch = tid & 7;
    u32x4 kreg, vreg, kreg2 = (u32x4){0u, 0u, 0u, 0u}, vreg2 = (u32x4){0u, 0u, 0u, 0u}; float ckreg = 0.f, ckreg2 = 0.f;
    { const size_t r = rowb + skey; kreg = *(const u32x4*)(KB + r * 512 + h * 64 + sch * 8); vreg = *(const u32x4*)(VB + r * 512 + h * 64 + sch * 8); if (tid < 64) ckreg = CUM[(rowb + tid) * 8 + h] * LOG2E; }
    *(LAS u32x4*)(lds + AT_K + skey * 144 + sch * 16) = kreg; *(LAS u32x4*)(lds + AT_V + skey * 160 + sch * 16) = vreg; if (tid < 64) ((LAS float*)(lds + AT_CK))[tid] = ckreg;
    { const size_t r = rowb + 64 + skey; kreg = *(const u32x4*)(KB + r * 512 + h * 64 + sch * 8); vreg = *(const u32x4*)(VB + r * 512 + h * 64 + sch * 8); if (tid < 64) ckreg = CUM[(rowb + 64 + tid) * 8 + h] * LOG2E; }
    __syncthreads();
    for (int kt = 0; kt < NT; ++kt) {
        LAS unsigned char* bufc = lds + (kt & 1) * AT_BUF; LAS unsigned char* bufn = lds + ((kt + 1) & 1) * AT_BUF;
        const bool more = kt + 1 < NT;
        if (kt + 2 < NT) { const size_t r = rowb + (kt + 2) * 64 + skey; kreg2 = *(const u32x4*)(KB + r * 512 + h * 64 + sch * 8); vreg2 = *(const u32x4*)(VB + r * 512 + h * 64 + sch * 8);
            if (tid < 64) ckreg2 = CUM[(rowb + (kt + 2) * 64 + tid) * 8 + h] * LOG2E; }
        if (kt * 64 <= qw + 31) {
            const LAS float* CK = (const LAS float*)(bufc + AT_CK);
            f32x4 st[4][2];
#pragma unroll
            for (int kb = 0; kb < 4; ++kb) { const bf16x8 k0 = *(const LAS bf16x8*)(bufc + AT_K + (kb * 16 + l15) * 144 + quad * 16), k1 = *(const LAS bf16x8*)(bufc + AT_K + (kb * 16 + l15) * 144 + 64 + quad * 16);
                const f32x4 ckv = *(const LAS f32x4*)(CK + kb * 16 + quad * 4);
#pragma unroll
                for (int qq = 0; qq < 2; ++qq) { const f32x4 ci = (f32x4){cq[qq] - ckv[0], cq[qq] - ckv[1], cq[qq] - ckv[2], cq[qq] - ckv[3]};
                    st[kb][qq] = MFMA16(k0, qf[qq][0], ci); st[kb][qq] = MFMA16(k1, qf[qq][1], st[kb][qq]); } }
            if (kt * 64 + 63 > qw) {
#pragma unroll
                for (int kb = 0; kb < 4; ++kb)
#pragma unroll
                    for (int qq = 0; qq < 2; ++qq)
#pragma unroll
                        for (int j = 0; j < 4; ++j) if (kt * 64 + kb * 16 + quad * 4 + j > qw + qq * 16 + l15) st[kb][qq][j] = -INFINITY; }
#pragma unroll
            for (int qq = 0; qq < 2; ++qq) { float mx = fmaxf(fmaxf(st[0][qq][0], st[0][qq][1]), fmaxf(st[0][qq][2], st[0][qq][3]));
#pragma unroll
                for (int kb = 1; kb < 4; ++kb) mx = fmaxf(mx, fmaxf(fmaxf(st[kb][qq][0], st[kb][qq][1]), fmaxf(st[kb][qq][2], st[kb][qq][3])));
                mx = xmax16_32(mx);
                const float mnew = fmaxf(mrun[qq], mx), alpha = __builtin_amdgcn_exp2f(mrun[qq] - mnew); mrun[qq] = mnew; float ps = 0.f;
#pragma unroll
                for (int kb = 0; kb < 4; ++kb)
#pragma unroll
                    for (int j = 0; j < 4; ++j) { const float p = __builtin_amdgcn_exp2f(st[kb][qq][j] - mnew); st[kb][qq][j] = p; ps += p; }
                lrun[qq] = lrun[qq] * alpha + ps;
#pragma unroll
                for (int d = 0; d < 4; ++d) o[qq][d] = o[qq][d] * alpha; }
#pragma unroll
            for (int c = 0; c < 2; ++c) { bf16x8 pf[2];
#pragma unroll
                for (int qq = 0; qq < 2; ++qq) pf[qq] = pack8(st[2 * c][qq], st[2 * c + 1][qq]);
#pragma unroll
                for (int d = 0; d < 4; ++d) { LAS unsigned char* vp = bufc + AT_V + (32 * c + quad * 4 + (l15 >> 2)) * 160 + d * 32 + (lane & 3) * 8;
                    const s16x4 r1 = tr_read(vp), r2 = tr_read(vp + 16 * 160);
                    const bf16x8 vf = (bf16x8){r1[0], r1[1], r1[2], r1[3], r2[0], r2[1], r2[2], r2[3]};
#pragma unroll
                    for (int qq = 0; qq < 2; ++qq) o[qq][d] = MFMA16(vf, pf[qq], o[qq][d]); } }
        }
        if (more) { *(LAS u32x4*)(bufn + AT_K + skey * 144 + sch * 16) = kreg; *(LAS u32x4*)(bufn + AT_V + skey * 160 + sch * 16) = vreg; if (tid < 64) ((LAS float*)(bufn + AT_CK))[tid] = ckreg; }
        kreg = kreg2; vreg = vreg2; ckreg = ckreg2;
        __syncthreads();
    }
#pragma unroll
    for (int qq = 0; qq < 2; ++qq) { const float inv = 1.0f / xsum16_32(lrun[qq]);
        bf16_t* orow = MIX + (rowb + qw + qq * 16 + l15) * DM + h * 64 + quad * 4;
#pragma unroll
        for (int d = 0; d < 4; ++d) { const f32x4 v = o[qq][d] * inv; u32x2 w; w.x = cvt_pk_bf16(v[0], v[1]); w.y = cvt_pk_bf16(v[2], v[3]); *(u32x2*)(orow + d * 16) = w; } }
}
__device__ __forceinline__ bf16x8 ld8f(const float* p) { const f32x4 x = __builtin_nontemporal_load((const f32x4*)p), y = __builtin_nontemporal_load((const f32x4*)(p + 4)); return pack8(x, y); }
__device__ __forceinline__ void attn_sample_unit(ArgsK& a, LAS unsigned char* lds, int b, int h, int tid, int wave, int lane) {
    const int l15 = lane & 15, quad = lane >> 4;
    const bf16_t* QB = (const bf16_t*)(a.ws + WS_QB); const bf16_t* KB = (const bf16_t*)(a.ws + WS_KB); const bf16_t* VB = (const bf16_t*)(a.ws + WS_VB);
    const float* CUM = (const float*)(a.ws + WS_CUMS) + ((size_t)b * CTOT) * 8 + h; bf16_t* MIX = (bf16_t*)(a.ws + WS_MIX);
    const size_t rs = (size_t)MP + b * DSEQ;
    const float* ckb = a.in[2] + ((size_t)b * PASTL) * 512 + h * 64; const float* cvb = a.in[3] + ((size_t)b * PASTL) * 512 + h * 64;
    bf16x8 qf[2];
#pragma unroll
    for (int ks = 0; ks < 2; ++ks) qf[ks] = *(const bf16x8*)(QB + (rs + l15) * 512 + h * 64 + ks * 32 + quad * 8);
    const float cq = CUM[(size_t)(PASTL + l15) * 8] * LOG2E;
    f32x4 o[4]; float mrun = -INFINITY, lrun = 0.f;
#pragma unroll
    for (int d = 0; d < 4; ++d) o[d] = (f32x4){0.f, 0.f, 0.f, 0.f};
    const int nch = (wave == 0) ? 9 : 8;
    for (int ch = 0; ch < nch; ++ch) {
        const bool nw = (ch == 8); const int k0 = wave * 256 + ch * 32;
        f32x4 st[2];
        if (!nw) {
#pragma unroll
            for (int kb = 0; kb < 2; ++kb) { const float* kp = ckb + (size_t)(k0 + kb * 16 + l15) * 512 + quad * 8;
                st[kb] = MFMA16(ld8f(kp), qf[0], ((f32x4){0.f, 0.f, 0.f, 0.f})); st[kb] = MFMA16(ld8f(kp + 32), qf[1], st[kb]);
#pragma unroll
                for (int j = 0; j < 4; ++j) st[kb][j] += cq - CUM[(size_t)(k0 + kb * 16 + quad * 4 + j) * 8] * LOG2E; }
        } else {
            const bf16_t* kp = KB + (rs + l15) * 512 + h * 64 + quad * 8;
            st[0] = MFMA16(*(const bf16x8*)kp, qf[0], ((f32x4){0.f, 0.f, 0.f, 0.f})); st[0] = MFMA16(*(const bf16x8*)(kp + 32), qf[1], st[0]);
#pragma unroll
            for (int j = 0; j < 4; ++j) { float sv = st[0][j] + (cq - CUM[(size_t)(PASTL + quad * 4 + j) * 8] * LOG2E); if (quad * 4 + j > l15) sv = -INFINITY; st[0][j] = sv; st[1][j] = -INFINITY; }
        }
        float mx = fmaxf(fmaxf(fmaxf(st[0][0], st[0][1]), fmaxf(st[0][2], st[0][3])), fmaxf(fmaxf(st[1][0], st[1][1]), fmaxf(st[1][2], st[1][3])));
        mx = fmaxf(mx, __shfl_xor(mx, 16)); mx = fmaxf(mx, __shfl_xor(mx, 32));
        const float mnew = fmaxf(mrun, mx), alpha = __builtin_amdgcn_exp2f(mrun - mnew); mrun = mnew; float ps = 0.f;
#pragma unroll
        for (int kb = 0; kb < 2; ++kb)
#pragma unroll
            for (int j = 0; j < 4; ++j) { const float p = __builtin_amdgcn_exp2f(st[kb][j] - mnew); st[kb][j] = p; ps += p; }
        lrun = lrun * alpha + ps;
        const bf16x8 pf = pack8(st[0], st[1]);
#pragma unroll
        for (int d = 0; d < 4; ++d) { f32x4 lo, hi;
            if (!nw) { const float* vp = cvb + (size_t)(k0 + quad * 4) * 512 + d * 16 + l15;
#pragma unroll
                for (int j = 0; j < 4; ++j) { lo[j] = __builtin_nontemporal_load(vp + (size_t)j * 512); hi[j] = __builtin_nontemporal_load(vp + (size_t)(16 + j) * 512); } }
            else { const bf16_t* vp = VB + (rs + quad * 4) * 512 + h * 64 + d * 16 + l15;
#pragma unroll
                for (int j = 0; j < 4; ++j) { lo[j] = bf2f(vp[(size_t)j * 512]); hi[j] = 0.f; } }
            o[d] = MFMA16(pack8(lo, hi), pf, o[d] * alpha); }
    }
    lrun += __shfl_xor(lrun, 16); lrun += __shfl_xor(lrun, 32);
    LAS float* Ml = (LAS float*)lds; LAS float* Ll = Ml + 128; LAS float* Ol = Ll + 128;
    if (quad == 0) { Ml[wave * 16 + l15] = mrun; Ll[wave * 16 + l15] = lrun; }
#pragma unroll
    for (int d = 0; d < 4; ++d) *(LAS f32x4*)(Ol + (wave * 16 + l15) * 64 + d * 16 + quad * 4) = o[d];
    __syncthreads();
    { const int q = tid >> 5, d0 = (tid & 31) * 2; float mm = -INFINITY;
#pragma unroll
      for (int w = 0; w < 8; ++w) mm = fmaxf(mm, Ml[w * 16 + q]);
      float L = 0.f, x0 = 0.f, x1 = 0.f;
#pragma unroll
      for (int w = 0; w < 8; ++w) { const float f = __builtin_amdgcn_exp2f(Ml[w * 16 + q] - mm); L += Ll[w * 16 + q] * f; x0 += Ol[(w * 16 + q) * 64 + d0] * f; x1 += Ol[(w * 16 + q) * 64 + d0 + 1] * f; }
      const float inv = 1.0f / L;
      *(unsigned*)(MIX + (rs + q) * DM + h * 64 + d0) = cvt_pk_bf16(x0 * inv, x1 * inv); }
    __syncthreads();
}
constexpr int GT_ST = 0, GT_V = 1024, GT_VSTR = 288;
__device__ __forceinline__ void gate_prompt_unit(ArgsK& a, LAS unsigned char* lds, int n, int tid, int wave, int lane) {
    const int l15 = lane & 15, quad = lane >> 4; const size_t r0 = (size_t)n * 128;
    const bf16_t* VR = (const bf16_t*)(a.ws + WS_VR); const bf16_t* U = (const bf16_t*)(a.ws + WS_U); bf16_t* UG = (bf16_t*)(a.ws + WS_UG); const bf16_t* WSM = (const bf16_t*)(a.ws + WS_WSM);
    LAS float* ST = (LAS float*)(lds + GT_ST);
    for (int rr = 0; rr < 16; rr += 4) {
        f32x4 v[4][4];
#pragma unroll
        for (int q = 0; q < 4; ++q) { const bf16_t* vr = VR + (r0 + wave * 16 + rr + q) * DM;
#pragma unroll
            for (int j = 0; j < 4; ++j) v[q][j] = ({ const u32x2 w_ = ((const u32x2*)vr)[lane + 64 * j]; (f32x4){bf2f(w_.x & 0xffff), bf2f(w_.x >> 16), bf2f(w_.y & 0xffff), bf2f(w_.y >> 16)}; }); }
#pragma unroll
        for (int q = 0; q < 4; ++q) { float s = 0.f;
#pragma unroll
            for (int j = 0; j < 4; ++j) s += (v[q][j][0] + v[q][j][1]) + (v[q][j][2] + v[q][j][3]);
            const float mean = wave_sum(s) * (1.f / DM); float s2 = 0.f;
#pragma unroll
            for (int j = 0; j < 4; ++j) { const f32x4 d = v[q][j] - mean; s2 += (d[0] * d[0] + d[1] * d[1]) + (d[2] * d[2] + d[3] * d[3]); }
            const float rstd = rsqrtf(wave_sum(s2) * (1.f / DM) + 1e-5f);
            if (lane == 0) { ST[(wave * 16 + rr + q) * 2] = mean; ST[(wave * 16 + rr + q) * 2 + 1] = rstd; } } }
    __syncthreads();
    const int sch = tid & 31, srb = tid >> 5;
    const int t = wave * 16 + l15, nch = (wave < 4) ? 2 : 4;
    f32x4 xr[8];
#pragma unroll
    for (int i = 0; i < 8; ++i) xr[i] = ({ const u32x2 w_ = *(const u32x2*)(VR + (r0 + srb + 16 * i) * DM + sch * 4); (f32x4){bf2f(w_.x & 0xffff), bf2f(w_.x >> 16), bf2f(w_.y & 0xffff), bf2f(w_.y >> 16)}; });
    for (int g = 0; g < 8; ++g) {
        { const f32x4 lg = *(const f32x4*)(a.in[25] + g * 128 + sch * 4), lb = *(const f32x4*)(a.in[26] + g * 128 + sch * 4);
#pragma unroll
          for (int i = 0; i < 8; ++i) { const int row = srb + 16 * i; const float mean = ST[row * 2], rstd = ST[row * 2 + 1];
              const f32x4 x = (xr[i] - mean) * rstd * lg + lb; u32x2 w; w.x = cvt_pk_bf16(x[0], x[1]); w.y = cvt_pk_bf16(x[2], x[3]);
              *(LAS u32x2*)(lds + GT_V + row * GT_VSTR + sch * 8) = w; } }
        __syncthreads();
        if (g + 1 < 8) {
#pragma unroll
            for (int i = 0; i < 8; ++i) xr[i] = ({ const u32x2 w_ = __builtin_nontemporal_load((const u32x2*)(VR + (r0 + srb + 16 * i) * DM + (g + 1) * 128 + sch * 4)); (f32x4){bf2f(w_.x & 0xffff), bf2f(w_.x >> 16), bf2f(w_.y & 0xffff), bf2f(w_.y >> 16)}; }); }
        u32x2 uw[8];
#pragma unroll
        for (int cb = 0; cb < 8; ++cb) uw[cb] = __builtin_nontemporal_load((const u32x2*)(U + (r0 + t) * DM + g * 128 + cb * 16 + quad * 4));
        f32x4 acc[8];
#pragma unroll
        for (int cb = 0; cb < 8; ++cb) acc[cb] = (f32x4){0.f, 0.f, 0.f, 0.f};
        for (int c = 0; c < nch; ++c) { const bf16_t* wp = WSM + ((size_t)(g * 128 + t)) * 128 + 32 * c + quad * 4;
            const u32x2 w1 = *(const u32x2*)wp, w2 = *(const u32x2*)(wp + 16); const bf16x8 wf = __builtin_bit_cast(bf16x8, ((u32x4){w1.x, w1.y, w2.x, w2.y}));
#pragma unroll
            for (int cb = 0; cb < 8; ++cb) { LAS unsigned char* vp = lds + GT_V + (32 * c + quad * 4 + (l15 >> 2)) * GT_VSTR + cb * 32 + (lane & 3) * 8;
                const s16x4 r1 = tr_read(vp), r2 = tr_read(vp + 16 * GT_VSTR);
                acc[cb] = MFMA16(((bf16x8){r1[0], r1[1], r1[2], r1[3], r2[0], r2[1], r2[2], r2[3]}), wf, acc[cb]); } }
        const float bias = a.in[28][g * 128 + t];
#pragma unroll
        for (int cb = 0; cb < 8; ++cb) { const size_t off = (r0 + t) * DM + g * 128 + cb * 16 + quad * 4;
            const f32x4 sp = acc[cb] + bias; u32x2 w; w.x = cvt_pk_bf16(bf2f(uw[cb].x & 0xffff) * sp[0], bf2f(uw[cb].x >> 16) * sp[1]); w.y = cvt_pk_bf16(bf2f(uw[cb].y & 0xffff) * sp[2], bf2f(uw[cb].y >> 16) * sp[3]);
            *(u32x2*)(UG + off) = w; }
        __syncthreads();
    }
}
__device__ __forceinline__ void gate_sample_unit(ArgsK& a, LAS unsigned char* lds, int b, int g, int tid, int wave, int lane) {
    const bf16_t* VR = (const bf16_t*)(a.ws + WS_VR); const bf16_t* U = (const bf16_t*)(a.ws + WS_U); bf16_t* UG = (bf16_t*)(a.ws + WS_UG);
    LAS float* VL = (LAS float*)lds;
    const size_t rs = (size_t)MP + b * DSEQ;
    for (int rr = 0; rr < 2; ++rr) { const int t = wave * 2 + rr; const bf16_t* vr = VR + (rs + t) * DM; f32x4 v[4]; float s = 0.f;
#pragma unroll
        for (int j = 0; j < 4; ++j) { const u32x2 w_ = ((const u32x2*)vr)[lane + 64 * j]; v[j] = (f32x4){bf2f(w_.x & 0xffff), bf2f(w_.x >> 16), bf2f(w_.y & 0xffff), bf2f(w_.y >> 16)}; s += (v[j][0] + v[j][1]) + (v[j][2] + v[j][3]); }
        const float mean = wave_sum(s) * (1.f / DM); float s2 = 0.f;
#pragma unroll
        for (int j = 0; j < 4; ++j) { const f32x4 d = v[j] - mean; s2 += (d[0] * d[0] + d[1] * d[1]) + (d[2] * d[2] + d[3] * d[3]); }
        const float rstd = rsqrtf(wave_sum(s2) * (1.f / DM) + 1e-5f);
#pragma unroll
        for (int j = 0; j < 4; ++j) if (((lane + 64 * j) >> 5) == g) {
            const int c4 = lane + 64 * j;
            const f32x4 o = (v[j] - mean) * rstd * ((const f32x4*)a.in[25])[c4] + ((const f32x4*)a.in[26])[c4];
            *(LAS f32x4*)(VL + t * 128 + (c4 - 32 * g) * 4) = o; ((f32x4*)(a.out + O_GVS + ((size_t)b * DSEQ + t) * DM))[c4] = o; } }
    __syncthreads();
    { const int c = tid & 127, tq = (tid >> 7) * 4; float vv[16];
#pragma unroll
      for (int s = 0; s < 16; ++s) vv[s] = VL[s * 128 + c];
#pragma unroll
      for (int q = 0; q < 4; ++q) { const int t = tq + q; const float* wr = a.in[27] + ((size_t)(g * 128 + t)) * 128; float sp = a.in[28][g * 128 + t];
#pragma unroll
          for (int s = 0; s < 16; ++s) sp += wr[s] * vv[s];
          const size_t off = (rs + t) * DM + g * 128 + c;
          UG[off] = (bf16_t)(cvt_pk_bf16(bf2f(U[off]) * sp, 0.f) & 0xffffu); } }
    __syncthreads();
}
#define XB_TMO      128
#define XB_XCNT(j)  (256  + 64 * (j))
#define XB_XSUB(j)  (1280 + 64 * (j))
#define XB_XGEN(j)  (2304 + 64 * (j))
#define XB_TOP      3328
#define XB_TOPGEN   3392
#define XCD_BAR_WORDS 3456
#define XB_SPIN_CAP (1u << 18)

__device__ __forceinline__ unsigned xb_ld(unsigned* p)              { return __hip_atomic_load(p, __ATOMIC_RELAXED, __HIP_MEMORY_SCOPE_AGENT); }
__device__ __forceinline__ unsigned xb_add(unsigned* p, unsigned v) { return __hip_atomic_fetch_add(p, v, __ATOMIC_RELAXED, __HIP_MEMORY_SCOPE_AGENT); }
__device__ __forceinline__ unsigned xb_xcc_id() { return (unsigned)__builtin_amdgcn_s_getreg((3 << 11) | 20) & 0xFu; }
#define XB_SPIN(cond, bar) do { unsigned _sp = 0; while (cond) { __builtin_amdgcn_s_sleep(1); \
    if ((++_sp & 255u) == 0u) { if (xb_ld(&(bar)[XB_TMO])) break; if (_sp > XB_SPIN_CAP) { atomicAdd(&(bar)[XB_TMO], 1u); break; } } } } while (0)

struct XcdBarrier {
    unsigned* bar; unsigned x; unsigned G;
    volatile LAS unsigned* st;
};

__device__ __forceinline__ XcdBarrier xcd_barrier_post(unsigned* bar, volatile LAS unsigned* st) {
    XcdBarrier b; b.bar = bar; b.x = xb_xcc_id(); b.st = st; b.G = 0;
    if (threadIdx.x == 0) (void)xb_add(&bar[XB_XCNT(b.x)], 1u);
    return b;
}
__device__ __forceinline__ void xcd_barrier_complete(unsigned* bar, unsigned x, unsigned& nloc, unsigned& nx, const unsigned G) {
    unsigned sum, cnt, mine, sp = 0u;
    for (;;) {
        sum = 0u; cnt = 0u; mine = 0u;
#pragma unroll
        for (unsigned j = 0; j < 16; ++j) { const unsigned c = xb_ld(&bar[XB_XCNT(j)]); sum += c; cnt += (c > 0u) ? 1u : 0u; mine = (j == x) ? c : mine; }
        if (sum == G) break;
        __builtin_amdgcn_s_sleep(1);
        if ((++sp & 255u) == 0u) { if (xb_ld(&bar[XB_TMO])) break; if (sp > XB_SPIN_CAP) { atomicAdd(&bar[XB_TMO], 1u); break; } }
    }
    nloc = mine > 0u ? mine : 1u; nx = cnt > 0u ? cnt : 1u;
}

__device__ __forceinline__ void xcd_barrier(const XcdBarrier& b) {
    asm volatile("s_waitcnt vmcnt(0)" ::: "memory");
    __syncthreads();
    if (threadIdx.x == 0) {
        unsigned* bar = b.bar;
        __builtin_amdgcn_s_waitcnt(0);
        unsigned nloc = b.st[0], nx = b.st[1];
        if (nloc == 0u) { xcd_barrier_complete(bar, b.x, nloc, nx, b.G); b.st[0] = nloc; b.st[1] = nx; }
        const unsigned old = xb_add(&bar[XB_XSUB(b.x)], 1u);
        const unsigned gen = old / nloc;
        if (old + 1u == (gen + 1u) * nloc) {
            __builtin_amdgcn_fence(__ATOMIC_RELEASE, "agent");
            asm volatile("s_waitcnt vmcnt(0)" ::: "memory");
            const unsigned og = xb_add(&bar[XB_TOP], 1u);
            const unsigned tg = og / nx;
            if (og + 1u == (tg + 1u) * nx) xb_add(&bar[XB_TOPGEN], 1u);
            else XB_SPIN(xb_ld(&bar[XB_TOPGEN]) == tg, bar);
            __builtin_amdgcn_fence(__ATOMIC_ACQUIRE, "agent");
            xb_add(&bar[XB_XGEN(b.x)], 1u);
            asm volatile("s_waitcnt vmcnt(0)" ::: "memory");
        } else {
            XB_SPIN(xb_ld(&bar[XB_XGEN(b.x)]) == gen, bar);
            __builtin_amdgcn_fence(__ATOMIC_ACQUIRE, "agent");
            asm volatile("s_waitcnt vmcnt(0)" ::: "memory");
        }
    }
    __syncthreads();
}

constexpr int N_PHASES = 23;
template <class Epi> __device__ __forceinline__ void run_gemm(LAS unsigned char* lds, const bf16_t* A, const bf16_t* Bt, int N, int K, const Epi& E, int G, int bid, int tid) {
    pg8::Gemm g{A, Bt, M, N, K}; pg8::StaticOrder S; S.init(M, N, G, bid);
    pg8::gemm_phase<Epi, pg8::StaticOrder>(lds, g, S, E, tid);
}
__global__ void __launch_bounds__(512, 2) mega_fwd(Args a_) {
    extern __shared__ __attribute__((aligned(16))) unsigned char lds_raw[];
    LAS unsigned char* lds = (LAS unsigned char*)lds_raw;
    if (threadIdx.x < 2) ((volatile LAS unsigned*)(lds + 131072 + 64))[threadIdx.x] = 0u;
    __syncthreads();
    XcdBarrier gbar = xcd_barrier_post((unsigned*)(a_.ws + WS_CTL), (volatile LAS unsigned*)(lds + 131072 + 64)); gbar.G = (unsigned)a_.G;
    const int ph_lo = a_.ph_lo, ph_hi = a_.ph_hi;
    for (int ph = ph_lo; ph < ph_hi; ++ph) {
        ArgsK* ap = (ArgsK*)__builtin_amdgcn_kernarg_segment_ptr();
        asm volatile("" : "+s"(ap));
        ArgsK& a = *ap;
        unsigned char* ws = a.ws;
        int tid = threadIdx.x; asm volatile("" : "+v"(tid));
        int bid = blockIdx.x, G = a.G; asm volatile("" : "+s"(bid), "+s"(G));
        const int lane = tid & 63, wave = __builtin_amdgcn_readfirstlane(tid >> 6), gw = bid * 8 + wave, NGW = G * 8;
        int kind, idx;
        const int rawp = a.seq[ph]; const int php = rawp & 0x7f;
        switch (php) {
            case 0: kind = 0; idx = 0; break;
            case 1: kind = 1; idx = 0; break;  case 2: kind = 2; idx = 0; break;  case 3: kind = 3; idx = 0; break;
            case 4: kind = 4; idx = 0; break;  case 5: kind = 5; idx = 0; break;  case 6: kind = 6; idx = 0; break;  case 7: kind = 7; idx = 0; break;
            case 8: kind = 2; idx = 4; break;  case 9: kind = 3; idx = 1; break;
            case 10: kind = 1; idx = 1; break; case 11: kind = 2; idx = 1; break; case 12: kind = 3; idx = 2; break;
            case 13: kind = 1; idx = 2; break; case 14: kind = 2; idx = 2; break; case 15: kind = 3; idx = 3; break;
            case 16: kind = 8; idx = 0; break; case 17: kind = 9; idx = 0; break; case 18: kind = 2; idx = 5; break; case 19: kind = 3; idx = 4; break;
            case 20: kind = 1; idx = 3; break; case 21: kind = 2; idx = 3; break; case 22: kind = 3; idx = 5; break; case 24: kind = 7; idx = 1; break; default: kind = 10; idx = 0; break;
        }
        if (kind == 0) phase_prologue(a, lds, gw, NGW, wave, lane);
        else if (kind == 1) { EpiSwiglu E{(bf16_t*)(ws + WS_BIG)}; run_gemm(lds, (const bf16_t*)(ws + WS_HN), (const bf16_t*)(ws + WS_WFI) + (size_t)idx * 2 * DFF * DM, 2 * DFF, DM, E, G, bid, tid); }
        else if (kind == 2 || kind == 6 || kind == 3) { const bool lo = (kind == 6), tail = (kind == 3);
            const int gi = tail ? (idx == 0 ? 0 : idx == 1 ? 4 : idx == 2 ? 1 : idx == 3 ? 2 : idx == 4 ? 5 : 3) : idx;
            EpiF32 E{(bf16_t*)(ws + WS_Y), DM, lo ? 1 : 0, EpiLora{(bf16_t*)(ws + WS_DEC), (bf16_t*)(ws + WS_AA), (bf16_t*)(ws + WS_GG), a.in[13], a.in[15]}};
            const bf16_t* A = lo ? (const bf16_t*)(ws + WS_LA) : (gi < 4 ? (const bf16_t*)(ws + WS_BIG) : (const bf16_t*)(ws + WS_HN));
            const bf16_t* Bt = lo ? (const bf16_t*)(ws + WS_WLO) : (gi < 4 ? (const bf16_t*)(ws + WS_WFO) + (size_t)gi * DM * DFF : (gi == 4 ? (const bf16_t*)(ws + WS_WEO) : (const bf16_t*)(ws + WS_WGO)));
            const int N_ = lo ? 1536 : DM, K_ = lo ? 256 : (gi < 4 ? DFF : DM);
            TailOrder S; S.init(lo ? M : MP, N_, G, bid); S.tmode = tail ? 1 : 0; S.tbid = bid;
            pg8::Gemm g{A, Bt, M, N_, K_};
            pg8::gemm_phase<EpiF32, TailOrder>(lds, g, S, E, tid);
            if (tail) { unsigned* cnt = (unsigned*)(ws + WS_CTL) + CW_TAIL + idx * 64;
                if (bid < N_TAIL) { asm volatile("s_waitcnt vmcnt(0)" ::: "memory"); __syncthreads();
                    if (tid == 0) { __builtin_amdgcn_fence(__ATOMIC_RELEASE, "agent"); asm volatile("s_waitcnt vmcnt(0)" ::: "memory"); (void)__hip_atomic_fetch_add(cnt, 1u, __ATOMIC_RELAXED, __HIP_MEMORY_SCOPE_AGENT); } }
                phase_rownorm(a, idx, bid, G, tid, wave, lane, cnt); }
        }
        else if (kind == 4) { EpiProj E{(bf16_t*)(ws + WS_QB), (bf16_t*)(ws + WS_KB), (bf16_t*)(ws + WS_VB), (bf16_t*)(ws + WS_PR), a.out, a.in[11]}; run_gemm(lds, (const bf16_t*)(ws + WS_HN), (const bf16_t*)(ws + WS_WEI), NEI, DM, E, G, bid, tid); }
        else if (kind == 5) phase_prep(a, gw, NGW, lane);
        else if (kind == 7) {
            if (idx == 0) { for (int i = 0; i < 4; ++i) for (int u = bid; u < 256; u += G) { const int b = u >> 3, h = u & 7;
                    attn_prompt_unit(a, lds, b, h, i, tid, wave, lane); attn_prompt_unit(a, lds, b, h, 7 - i, tid, wave, lane); }
                for (int u = bid; u < 256; u += G) attn_sample_unit(a, lds, u >> 3, u & 7, tid, wave, lane); }
            else for (int u = bid; u < 512; u += G) scan_unit(a, lds, u, tid, wave, lane);
        }
        else if (kind == 8) { EpiGelu E{(bf16_t*)(ws + WS_U), (bf16_t*)(ws + WS_VR)}; run_gemm(lds, (const bf16_t*)(ws + WS_HN), (const bf16_t*)(ws + WS_WGI), 2 * DM, DM, E, G, bid, tid); }
        else if (kind == 9) { for (int n = bid; n < 512; n += G) gate_prompt_unit(a, lds, n, tid, wave, lane);
               for (int u = bid; u < NB * 8; u += G) gate_sample_unit(a, lds, u >> 3, u & 7, tid, wave, lane); }
        if (ph + 1 < ph_hi && !(rawp & 0x80)) { if (a.pad == 0x7fffffff) cg::this_grid().sync();
            xcd_barrier(gbar); }
    }
}
extern "C" void kernel_launch(void* const* d_in, const int* in_sizes, int n_in, void* d_out, int out_size, void* d_ws, size_t ws_size, hipStream_t stream) {
    static int grid = 0;
    if (grid == 0) {
        if (n_in != 30 || (size_t)out_size != O_END || ws_size < WS_END) { fprintf(stderr, "kernel_launch: unexpected shapes (n_in %d, out %d, ws %zu)\n", n_in, out_size, ws_size); grid = -1; return; }
        { static const int exp_sz[30] = {67108864, 524288, 33554432, 33554432, 524288, 1048576, 57344, 12288, 23068672, 11534336, 3416064, 8, 1792, 512, 32768, 512, 32768, 65536, 512, 512, 512, 512, 512, 1048576, 2097152, 1024, 1024, 131072, 1024, 1048576};
          for (int i = 0; i < 30; ++i) if (in_sizes[i] != exp_sz[i]) { fprintf(stderr, "kernel_launch: input %d has %d elements, expected %d\n", i, in_sizes[i], exp_sz[i]); grid = -1; return; } }
        int dev = 0, cus = 0, per_cu = 0;
        (void)hipGetDevice(&dev); (void)hipDeviceGetAttribute(&cus, hipDeviceAttributeMultiprocessorCount, dev);
        if (hipFuncSetAttribute((const void*)mega_fwd, hipFuncAttributeMaxDynamicSharedMemorySize, LDS_BYTES) != hipSuccess) { fprintf(stderr, "kernel_launch: hipFuncSetAttribute failed\n"); grid = -1; return; }
        if (hipOccupancyMaxActiveBlocksPerMultiprocessor(&per_cu, (const void*)mega_fwd, 512, LDS_BYTES) != hipSuccess || per_cu < 1) { fprintf(stderr, "kernel_launch: occupancy query says %d\n", per_cu); per_cu = 1; }
        (void)hipGetLastError();
        grid = cus * 1;
        if (grid > 256) grid = 256;
    }
    if (grid < 0) return;
    Args a{};
    for (int i = 0; i < 30; ++i) a.in[i] = (const float*)d_in[i];
    a.out = (float*)d_out; a.ws = (unsigned char*)d_ws; a.G = grid;
    if (hipMemsetAsync((char*)d_ws + WS_CTL, 0, CTL_BYTES, stream) != hipSuccess) { fprintf(stderr, "kernel_launch: memset of the barrier words failed\n"); return; }
    int nsteps = 0;
    for (int p = 0; p < N_PHASES; ++p) { a.seq[nsteps++] = (unsigned char)(p == 6 ? (6 | 0x80) : p);
        if (p == 7) a.seq[nsteps++] = (unsigned char)24;
#ifdef PROBE_NULLS
        if (p == 0) for (int k = 0; k < PROBE_NULLS; ++k) a.seq[nsteps++] = (unsigned char)23;
#endif
#ifdef PROBE_DUP
        { const int dupl[] = PROBE_DUP; for (unsigned k = 0; k < sizeof(dupl) / sizeof(int); ++k) if (dupl[k] == p) a.seq[nsteps++] = (unsigned char)p; else if (dupl[k] == 24 && p == 7) a.seq[nsteps++] = (unsigned char)24; }
#endif
    }
    a.ph_lo = 0; a.ph_hi = nsteps; void* args[] = {&a};
    hipError_t e = hipLaunchCooperativeKernel((const void*)mega_fwd, dim3(grid), dim3(512), args, LDS_BYTES, stream);
    if (e != hipSuccess) fprintf(stderr, "cooperative launch failed: %s (grid %d)\n", hipGetErrorString(e), grid);
}
```

```cpp
#include <hip/hip_runtime.h>
#include <hip/hip_cooperative_groups.h>
#include <cstdio>
#include <cstdint>
namespace cg = cooperative_groups;
namespace pg8 {
#define PG8_LAS __attribute__((address_space(3)))
typedef unsigned short bf16_t;
typedef short bf16x8 __attribute__((ext_vector_type(8)));
typedef float f32x4 __attribute__((ext_vector_type(4)));
typedef unsigned u32x4 __attribute__((ext_vector_type(4)));
constexpr int BM = 256, BK = 64, HALF = 128, HTB = HALF * BK * 2  , STAGE_BYTES = 8 * HTB, NXCD = 8, WGM = 8;

__host__ __device__ __forceinline__ int lds_byte(int r, int c) { const int st = (r >> 4) * 2 + (c >> 5), rr = r & 15, cc = c & 31, ob = rr * 64 + cc * 2; return st * 1024 + (ob ^ (((ob >> 9) & 1) << 5)); }
__host__ __device__ __forceinline__ void stage_rc(int b, int& R, int& C) { const int st = b / 1024, sb = b % 1024, swz = sb ^ (((sb >> 9) & 1) << 5); R = (st >> 1) * 16 + swz / 64; C = (st & 1) * 32 + (swz % 64) / 2; }
__host__ __device__ __forceinline__ int perm32(int rho) { const int n = rho >> 4, i = rho & 15; return 8 * (i >> 2) + 4 * n + (i & 3); }

struct Unit { int pm, pn; };
struct Gemm { const bf16_t* A; const bf16_t* Bt; int M, N, K; };

struct StaticOrder {
    int nM, nN, nwg, G, c;
    __host__ __device__ void init(int M, int N, int G_, int c_) { nM = M / BM; nN = N / BM; nwg = nM * nN; G = G_; c = c_; }
    __host__ __device__ bool next(int i, Unit& u) const {
        const long L = (long)i * G + c; if (L >= nwg) return false;
        int wgid = (int)L; { const int q = nwg / NXCD, r = nwg % NXCD, xcd = wgid % NXCD, off = wgid / NXCD; wgid = (xcd < r ? xcd * (q + 1) : r * (q + 1) + (xcd - r) * q) + off; }
        const int nig = WGM * nN, gid = wgid / nig, fm = gid * WGM, gsz = (nM - fm) < WGM ? (nM - fm) : WGM;
        u.pm = fm + ((wgid % nig) % gsz); u.pn = (wgid % nig) / gsz; return true;
    }
    __device__ __forceinline__ void a_ready(const Unit&) const {}
    __device__ __forceinline__ void done(const Unit&) const {}
};
__device__ __forceinline__ unsigned cvt_pk_bf16(float lo, float hi) { unsigned r; asm volatile("v_cvt_pk_bf16_f32 %0, %1, %2" : "=v"(r) : "v"(lo), "v"(hi)); return r; }
typedef float f32x2 __attribute__((ext_vector_type(2)));
__device__ __forceinline__ f32x2 gelu_pk(f32x2 v) {
    const f32x2 av = __builtin_elementwise_abs(v), d = av * 0.2316418882f + 1.0f;
    f32x2 t; t.x = __builtin_amdgcn_rcpf(d.x); t.y = __builtin_amdgcn_rcpf(d.y);
    f32x2 q = t * 0.5307027145f + (-0.7265760135f); q = q * t + 0.7107068705f; q = q * t + (-0.142248368f); q = q * t + 0.127414796f; q = q * t;
    const f32x2 s = (v * v) * (-0.72134752044f);
    f32x2 e; e.x = __builtin_amdgcn_exp2f(s.x); e.y = __builtin_amdgcn_exp2f(s.y);
    const f32x2 m = v * (q * e), r = v - m;
    f32x2 o; o.x = v.x < 0.f ? m.x : r.x; o.y = v.y < 0.f ? m.y : r.y; return o;
}

template <class Epi, class Sched, bool ALIGN_EPI = true, bool SP2 = true>
__device__ __forceinline__ void gemm_phase(PG8_LAS unsigned char* lds, const Gemm g, const Sched& S, const Epi& E, const int tid) {
    const int wid = __builtin_amdgcn_readfirstlane(tid >> 6), lane = tid & 63, wr = wid >> 2, wc = wid & 3, fr = lane & 15, fq = lane >> 4;
    const int K = g.K, nt = K / BK;
    unsigned voffA[2], voffB[2];
#pragma unroll
    for (int i = 0; i < 2; ++i) { int R, C; stage_rc(tid * 16 + i * 8192, R, C); const int Rb = Epi::PERM ? ((R & ~31) + perm32(R & 31)) : R;
        voffA[i] = (unsigned)(R * K + C) * 2u; voffB[i] = (unsigned)(Rb * K + C) * 2u; }
    const size_t kstep = (size_t)(BK * 2);
    const size_t hstep = (size_t)HALF * K * 2;
    const size_t tstep = 2 * hstep;
    const unsigned ldsw = (unsigned)wid * 1024u;
    const int aoff = lds_byte(wr * 64 + fr, fq * 8), boff = lds_byte(wc * 32 + fr, fq * 8);
#define PG8_SA(b, h) (((b) * 2 + (h)) * HTB)
#define PG8_SB(b, h) ((4 + (b) * 2 + (h)) * HTB)
#define PG8_STAGE(bufoff, gbase, voff) do { _Pragma("unroll") for (int _i = 0; _i < 2; ++_i) \
        __builtin_amdgcn_global_load_lds((const unsigned*)((const char*)(gbase) + (voff)[_i]), (PG8_LAS unsigned*)(lds + (bufoff) + ldsw + _i * 8192), 16, 0, 0); } while (0)
#define PG8_LDA(dst, b, h) do { _Pragma("unroll") for (int m = 0; m < 4; ++m) _Pragma("unroll") for (int k = 0; k < 2; ++k) dst[m][k] = *(const PG8_LAS bf16x8*)(lds + PG8_SA(b, h) + aoff + m * 2048 + k * 1024); } while (0)
#define PG8_LDB(dst, b, h) do { _Pragma("unroll") for (int n = 0; n < 2; ++n) _Pragma("unroll") for (int k = 0; k < 2; ++k) dst[n][k] = *(const PG8_LAS bf16x8*)(lds + PG8_SB(b, h) + boff + n * 2048 + k * 1024); } while (0)
#define PG8_MMA(ai, bj, At, Bt) do { __builtin_amdgcn_s_setprio(1); _Pragma("unroll") for (int m = 0; m < 4; ++m) _Pragma("unroll") for (int n = 0; n < 2; ++n) _Pragma("unroll") for (int k = 0; k < 2; ++k) \
        acc[ai][bj][m][n] = __builtin_amdgcn_mfma_f32_16x16x32_bf16(Bt[n][k], At[m][k], acc[ai][bj][m][n], 0, 0, 0); __builtin_amdgcn_s_setprio(0); } while (0)
#define PG8_WAIT_V(n) asm volatile("s_waitcnt vmcnt(" #n ")" ::: "memory")
#define PG8_WAIT_L(n) asm volatile("s_waitcnt lgkmcnt(" #n ")" ::: "memory")
#define PG8_BAR __builtin_amdgcn_s_barrier()
#define PG8_SCHED __builtin_amdgcn_sched_barrier(0)
    Unit cur, nxt; int ui = 0;
    if (!S.next(0, cur)) return;
    f32x4 acc[2][2][4][2];
#pragma unroll
    for (int a = 0; a < 2; ++a)
#pragma unroll
        for (int b = 0; b < 2; ++b)
#pragma unroll
            for (int m = 0; m < 4; ++m)
#pragma unroll
                for (int n = 0; n < 2; ++n) acc[a][b][m][n] = (f32x4){0.f, 0.f, 0.f, 0.f};
    bf16x8 At[4][2], B0[2][2], B1[2][2];
    const char* cA = (const char*)g.A + (size_t)cur.pm * tstep; const char* cB = (const char*)g.Bt + (size_t)cur.pn * tstep;
    S.a_ready(cur);
    if constexpr (SP2) {
        PG8_STAGE(PG8_SB(0, 0), cB, voffB); PG8_STAGE(PG8_SB(0, 1), cB + hstep, voffB); PG8_STAGE(PG8_SA(0, 0), cA, voffA); PG8_STAGE(PG8_SA(0, 1), cA + hstep, voffA);
        if (wr == 1) PG8_BAR;
        PG8_WAIT_V(2); PG8_BAR;
        PG8_STAGE(PG8_SB(1, 0), cB + kstep, voffB); PG8_STAGE(PG8_SA(1, 0), cA + kstep, voffA); PG8_STAGE(PG8_SB(1, 1), cB + hstep + kstep, voffB);
        PG8_WAIT_V(6); PG8_BAR;
    } else {
        PG8_STAGE(PG8_SB(0, 0), cB, voffB); PG8_STAGE(PG8_SA(0, 0), cA, voffA); PG8_STAGE(PG8_SB(0, 1), cB + hstep, voffB); PG8_STAGE(PG8_SA(0, 1), cA + hstep, voffA);
        if (wr == 1) PG8_BAR;
        PG8_WAIT_V(4); PG8_BAR;
        PG8_STAGE(PG8_SB(1, 0), cB + kstep, voffB); PG8_STAGE(PG8_SA(1, 0), cA + kstep, voffA); PG8_STAGE(PG8_SB(1, 1), cB + hstep + kstep, voffB);
        PG8_WAIT_V(6); PG8_BAR;
    }
    for (;;) {
        const bool has_next = S.next(ui + 1, nxt);
        const char* nA = has_next ? (const char*)g.A + (size_t)nxt.pm * tstep : cA; const char* nB = has_next ? (const char*)g.Bt + (size_t)nxt.pn * tstep : cB;
        for (int t = 0; t < nt; t += 2) {
            const bool last = (t == nt - 2);
            const char* a1 = cA + (size_t)(t + 1) * kstep;
            const char* a2 = last ? nA : cA + (size_t)(t + 2) * kstep; const char* b2 = last ? nB : cB + (size_t)(t + 2) * kstep;
            const char* a3 = a2 + kstep; const char* b3 = b2 + kstep;
            if (last && has_next) S.a_ready(nxt);
            if constexpr (SP2) {
            PG8_LDB(B0, 0, 0); PG8_LDB(B1, 0, 1); PG8_SCHED; PG8_LDA(At, 0, 0); PG8_STAGE(PG8_SA(1, 1), a1 + hstep, voffA);
            PG8_WAIT_V(8); PG8_WAIT_L(0); PG8_BAR; PG8_MMA(0, 0, At, B0); PG8_MMA(0, 1, At, B1); PG8_BAR; PG8_SCHED;
            PG8_LDA(At, 0, 1); PG8_STAGE(PG8_SB(0, 0), b2, voffB); PG8_STAGE(PG8_SB(0, 1), b2 + hstep, voffB); PG8_STAGE(PG8_SA(0, 0), a2, voffA);
            PG8_WAIT_V(8); PG8_WAIT_L(0); PG8_BAR; PG8_MMA(1, 0, At, B0); PG8_MMA(1, 1, At, B1); PG8_BAR; PG8_SCHED;
            PG8_LDB(B0, 1, 0); PG8_LDB(B1, 1, 1); PG8_SCHED; PG8_LDA(At, 1, 0); PG8_STAGE(PG8_SA(0, 1), a2 + hstep, voffA);
            PG8_WAIT_V(8); PG8_WAIT_L(0); PG8_BAR; PG8_MMA(0, 0, At, B0); PG8_MMA(0, 1, At, B1); PG8_BAR; PG8_SCHED;
            PG8_LDA(At, 1, 1); PG8_STAGE(PG8_SB(1, 0), b3, voffB); PG8_STAGE(PG8_SB(1, 1), b3 + hstep, voffB); PG8_STAGE(PG8_SA(1, 0), a3, voffA);
            PG8_WAIT_V(8); PG8_WAIT_L(0); PG8_BAR; PG8_MMA(1, 0, At, B0); PG8_MMA(1, 1, At, B1); PG8_BAR; PG8_SCHED;
            } else {
            PG8_LDB(B0, 0, 0); PG8_SCHED; PG8_LDA(At, 0, 0); PG8_STAGE(PG8_SA(1, 1), a1 + hstep, voffA);
            PG8_WAIT_L(8); PG8_BAR; PG8_WAIT_L(0); PG8_MMA(0, 0, At, B0); PG8_BAR; PG8_SCHED;
            PG8_LDB(B1, 0, 1); PG8_STAGE(PG8_SB(0, 0), b2, voffB);
            PG8_BAR; PG8_WAIT_L(0); PG8_MMA(0, 1, At, B1); PG8_BAR;
            PG8_LDA(At, 0, 1); PG8_STAGE(PG8_SA(0, 0), a2, voffA);
            PG8_BAR; PG8_WAIT_L(0); PG8_MMA(1, 0, At, B0); PG8_BAR; PG8_SCHED;
            PG8_STAGE(PG8_SB(0, 1), b2 + hstep, voffB);
            PG8_WAIT_V(6); PG8_BAR; PG8_MMA(1, 1, At, B1); PG8_BAR;
            PG8_LDB(B0, 1, 0); PG8_SCHED; PG8_LDA(At, 1, 0); PG8_STAGE(PG8_SA(0, 1), a2 + hstep, voffA);
            PG8_WAIT_L(8); PG8_BAR; PG8_WAIT_L(0); PG8_MMA(0, 0, At, B0); PG8_BAR; PG8_SCHED;
            PG8_LDB(B1, 1, 1); PG8_STAGE(PG8_SB(1, 0), b3, voffB);
            PG8_BAR; PG8_WAIT_L(0); PG8_MMA(0, 1, At, B1); PG8_BAR;
            PG8_LDA(At, 1, 1); PG8_STAGE(PG8_SA(1, 0), a3, voffA);
            PG8_BAR; PG8_WAIT_L(0); PG8_MMA(1, 0, At, B0); PG8_BAR; PG8_SCHED;
            PG8_STAGE(PG8_SB(1, 1), b3 + hstep, voffB);
            PG8_WAIT_V(6); PG8_BAR; PG8_MMA(1, 1, At, B1); PG8_BAR;
            }
        }
        if constexpr (ALIGN_EPI) { if (wr == 0) PG8_BAR; }
        if constexpr (!Epi::AFTER_DRAIN) { E(acc, cur, wr, wc, fr, fq); S.done(cur); }
        if (!has_next) break;
#pragma unroll
        for (int a = 0; a < 2; ++a)
#pragma unroll
            for (int b = 0; b < 2; ++b)
#pragma unroll
                for (int m = 0; m < 4; ++m)
#pragma unroll
                    for (int n = 0; n < 2; ++n) acc[a][b][m][n] = (f32x4){0.f, 0.f, 0.f, 0.f};
        cur = nxt; cA = nA; cB = nB; ++ui;
        if constexpr (ALIGN_EPI) { if (wr == 1) PG8_BAR; }
    }
    PG8_WAIT_V(0);
    if constexpr (!ALIGN_EPI) { if (wr == 0) PG8_BAR; }
    PG8_BAR;
    if constexpr (Epi::AFTER_DRAIN) { E.fused(acc, cur, wr, wc, fr, fq, lds, wid, lane); S.done(cur); }
#undef PG8_SA
#undef PG8_SB
#undef PG8_STAGE
#undef PG8_LDA
#undef PG8_LDB
#undef PG8_MMA
#undef PG8_WAIT_V
#undef PG8_WAIT_L
#undef PG8_BAR
#undef PG8_SCHED
}
}
#define LAS __attribute__((address_space(3)))
using pg8::bf16_t; using pg8::bf16x8; using pg8::f32x4; using pg8::u32x4; using pg8::f32x2; using pg8::cvt_pk_bf16;
typedef short s16x4 __attribute__((ext_vector_type(4)));
typedef unsigned u32x2 __attribute__((ext_vector_type(2)));
typedef short v4i16_t __attribute__((ext_vector_type(4)));

constexpr int DM = 1024, NB = 32, SEQ = 2048, MP = NB * SEQ, DSEQ = 16, MS = NB * DSEQ, M = MP + MS;
constexpr int FW = 512, RWC = 1792, DFF = 2816, NEI = 3584, PASTL = 2048, CTOT = PASTL + DSEQ;
constexpr float LOG2E = 1.4426950408889634f, QSCALE = 0.125f * LOG2E;
constexpr size_t O_YP = 0, O_YS = O_YP + (size_t)MP * DM, O_FKP = O_YS + (size_t)MS * DM, O_FVP = O_FKP + (size_t)MP * FW, O_FLP = O_FVP + (size_t)MP * FW,
    O_RSP = O_FLP + (size_t)MP * 8, O_RSHP = O_RSP + (size_t)NB * 8 * 64 * 64, O_FKS = O_RSHP + (size_t)NB * RWC, O_FVS = O_FKS + (size_t)MS * FW, O_FLS = O_FVS + (size_t)MS * FW,
    O_RSS = O_FLS + (size_t)MS * 8, O_RSHS = O_RSS + (size_t)NB * 8 * 64 * 64, O_GVS = O_RSHS + (size_t)NB * RWC, O_END = O_GVS + (size_t)MS * DM;
constexpr size_t MiB = 1u << 20, HMiB = 1u << 19, QMiB = 1u << 18;
constexpr size_t WS_WFI = 0, WS_WFO = 44 * MiB, WS_WEI = 66 * MiB, WS_WEO = 73 * MiB, WS_WGI = 75 * MiB, WS_WGO = 79 * MiB, WS_WLO = 81 * MiB, WS_WSM = 82 * MiB, WS_CUMP = 83 * MiB, WS_CUMS = 85 * MiB;
constexpr size_t WS_CTL = 88 * MiB, CTL_BYTES = 32768;
constexpr int CW_TAIL = 4096, N_TAIL = 8;
constexpr size_t WS_HN = 96 * MiB, WS_Y = 225 * MiB, WS_BIG = 483 * MiB, WS_KB = 838 * MiB, WS_VB = WS_KB + 129 * HMiB, WS_END = 1024 * MiB;
constexpr size_t WS_MIX = WS_HN, WS_DEC = WS_Y, WS_AA = WS_Y + 129 * MiB, WS_GG = WS_AA + 129 * HMiB;
constexpr size_t WS_QB = WS_BIG, WS_LA = WS_QB + 129 * HMiB, WS_PR = WS_LA + 129 * QMiB;
constexpr size_t WS_U = WS_BIG, WS_VR = WS_BIG + 129 * MiB, WS_UG = WS_HN;
static_assert((size_t)M * DM * 2 == 129 * MiB && (size_t)M * 512 * 2 == 129 * HMiB && (size_t)M * 256 * 2 == 129 * QMiB, "sizes");
static_assert(WS_PR + (size_t)M * RWC * 2 <= WS_KB && WS_BIG + (size_t)M * DFF * 2 <= WS_KB && WS_VR + (size_t)M * DM * 4 <= WS_END && WS_VB + 129 * HMiB <= WS_END, "ws map");
constexpr int LDS_BYTES = 147456;

struct Args { const float* in[30]; float* out; unsigned char* ws; int ph_lo, ph_hi, G, pad; unsigned char seq[64]; };
typedef const __attribute__((address_space(4))) Args ArgsK;

__device__ __forceinline__ float bf2f(unsigned short b) { return __uint_as_float(((unsigned)b) << 16); }
template <int CTRL> __device__ __forceinline__ float dppf(float v) { return __int_as_float(__builtin_amdgcn_update_dpp(0, __float_as_int(v), CTRL, 0xF, 0xF, false)); }
__device__ __forceinline__ float red8(float v) { v += dppf<0xB1>(v); v += dppf<0x4E>(v); v += dppf<0x141>(v); return v; }
__device__ __forceinline__ float wave_sum(float v) {
    v = red8(v); v += dppf<0x140>(v);
    { const auto r = __builtin_amdgcn_permlane16_swap(__float_as_uint(v), __float_as_uint(v), false, false); v = __uint_as_float(r[0]) + __uint_as_float(r[1]); }
    { const auto r = __builtin_amdgcn_permlane32_swap(__float_as_uint(v), __float_as_uint(v), false, false); v = __uint_as_float(r[0]) + __uint_as_float(r[1]); }
    return v;
}
__device__ __forceinline__ float sigmoidf_(float x) { return 1.0f / (1.0f + __expf(-x)); }
#define LDS_WAIT() asm volatile("s_waitcnt lgkmcnt(0)" ::: "memory")

struct EpiLora {
    bf16_t *DEC, *AA, *GG; const float *w0, *a0;
    __device__ __forceinline__ void operator()(const f32x4 (&acc)[2][2][4][2], const pg8::Unit& u, int wr, int wc, int fr, int fq) const {
        const int row0 = u.pm * 256 + wr * 64 + fr, pn = u.pn, cb = (pn & 1) * 256 + wc * 32 + 8 * fq;
        const float* offp = pn < 2 ? w0 : a0; bf16_t* O16 = pn < 2 ? DEC : (pn < 4 ? AA : GG);
#pragma unroll
        for (int ai = 0; ai < 2; ++ai)
#pragma unroll
            for (int m = 0; m < 4; ++m) { const size_t r = (size_t)(row0 + ai * 128 + m * 16);
#pragma unroll
                for (int bj = 0; bj < 2; ++bj) { const int c = cb + bj * 128; f32x4 v0 = acc[ai][bj][m][0], v1 = acc[ai][bj][m][1];
                    if (pn < 4) { v0 = v0 + *(const f32x4*)(offp + c); v1 = v1 + *(const f32x4*)(offp + c + 4);
#pragma unroll
                        for (int j = 0; j < 4; ++j) { v0[j] = __builtin_amdgcn_rcpf(1.0f + __builtin_amdgcn_exp2f(-LOG2E * v0[j])); v1[j] = __builtin_amdgcn_rcpf(1.0f + __builtin_amdgcn_exp2f(-LOG2E * v1[j])); } }
                    { u32x4 w; w.x = cvt_pk_bf16(v0[0], v0[1]); w.y = cvt_pk_bf16(v0[2], v0[3]); w.z = cvt_pk_bf16(v1[0], v1[1]); w.w = cvt_pk_bf16(v1[2], v1[3]); *(u32x4*)(O16 + r * 512 + c) = w; } } }
    }
};
struct EpiF32 {
    static constexpr bool PERM = true, AFTER_DRAIN = false;
    bf16_t* C; int ldc; int mode; EpiLora L;
    __device__ __forceinline__ void operator()(const f32x4 (&acc)[2][2][4][2], const pg8::Unit& u, int wr, int wc, int fr, int fq) const {
        if (mode) { L(acc, u, wr, wc, fr, fq); return; }
        const int row0 = u.pm * 256 + wr * 64 + fr, col0 = u.pn * 256 + wc * 32 + 8 * fq;
#pragma unroll
        for (int ai = 0; ai < 2; ++ai)
#pragma unroll
            for (int m = 0; m < 4; ++m) { bf16_t* rowp = C + (size_t)(row0 + ai * 128 + m * 16) * ldc + col0;
#pragma unroll
                for (int bj = 0; bj < 2; ++bj) { const f32x4 v0 = acc[ai][bj][m][0], v1 = acc[ai][bj][m][1];
                    u32x4 w; w.x = cvt_pk_bf16(v0[0], v0[1]); w.y = cvt_pk_bf16(v0[2], v0[3]); w.z = cvt_pk_bf16(v1[0], v1[1]); w.w = cvt_pk_bf16(v1[2], v1[3]); *(u32x4*)(rowp + bj * 128) = w; } }
    }
};
struct EpiSwiglu {
    static constexpr bool PERM = true, AFTER_DRAIN = false;
    bf16_t* H;
    __device__ __forceinline__ void operator()(const f32x4 (&acc)[2][2][4][2], const pg8::Unit& u, int wr, int wc, int fr, int fq) const {
        const int row0 = u.pm * 256 + wr * 64 + fr, col0 = u.pn * 128 + wc * 32 + 8 * fq;
#pragma unroll
        for (int ai = 0; ai < 2; ++ai)
#pragma unroll
            for (int m = 0; m < 4; ++m) { bf16_t* rowp = H + (size_t)(row0 + ai * 128 + m * 16) * DFF + col0;
                float hv[8];
#pragma unroll
                for (int n = 0; n < 2; ++n)
#pragma unroll
                    for (int j = 0; j < 4; ++j) { const float g = acc[ai][0][m][n][j], up = acc[ai][1][m][n][j];
                        hv[n * 4 + j] = g * __builtin_amdgcn_rcpf(1.0f + __builtin_amdgcn_exp2f(-g * LOG2E)) * up; }
                u32x4 w; w.x = cvt_pk_bf16(hv[0], hv[1]); w.y = cvt_pk_bf16(hv[2], hv[3]); w.z = cvt_pk_bf16(hv[4], hv[5]); w.w = cvt_pk_bf16(hv[6], hv[7]);
                *(u32x4*)rowp = w; }
    }
};
__device__ __forceinline__ float log_sigmoid_(float x) { return fminf(x, 0.f) - log1pf(expf(-fabsf(x))); }
struct EpiProj {
    static constexpr bool PERM = true, AFTER_DRAIN = false;
    bf16_t *QB, *KB, *VB, *PR; float* out; const float* bf;
    __device__ __forceinline__ void operator()(const f32x4 (&acc)[2][2][4][2], const pg8::Unit& u, int wr, int wc, int fr, int fq) const {
        const int row0 = u.pm * 256 + wr * 64 + fr, colt = wc * 32 + 8 * fq, pn = u.pn; const bool smp = u.pm >= 256;
        if (pn < 2) {
#pragma unroll
            for (int ai = 0; ai < 2; ++ai)
#pragma unroll
                for (int m = 0; m < 4; ++m) { bf16_t* rowp = QB + (size_t)(row0 + ai * 128 + m * 16) * 512 + pn * 256 + colt;
#pragma unroll
                    for (int bj = 0; bj < 2; ++bj) { const f32x4 v0 = acc[ai][bj][m][0] * QSCALE, v1 = acc[ai][bj][m][1] * QSCALE;
                        u32x4 w; w.x = cvt_pk_bf16(v0[0], v0[1]); w.y = cvt_pk_bf16(v0[2], v0[3]); w.z = cvt_pk_bf16(v1[0], v1[1]); w.w = cvt_pk_bf16(v1[2], v1[3]); *(u32x4*)(rowp + bj * 128) = w; } }
        } else if (pn < 6) {
            const int which = (pn - 2) >> 1, cb = ((pn - 2) & 1) * 256 + colt;
            bf16_t* B16 = which ? VB : KB;
            float* F32 = out + (smp ? (which ? O_FVS : O_FKS) : (which ? O_FVP : O_FKP));
#pragma unroll
            for (int ai = 0; ai < 2; ++ai)
#pragma unroll
                for (int m = 0; m < 4; ++m) { const int r = row0 + ai * 128 + m * 16; bf16_t* rowp = B16 + (size_t)r * 512 + cb; float* rowf = F32 + (size_t)(smp ? r - MP : r) * 512 + cb;
#pragma unroll
                    for (int bj = 0; bj < 2; ++bj) { const f32x4 v0 = acc[ai][bj][m][0], v1 = acc[ai][bj][m][1]; __builtin_nontemporal_store(v0, (f32x4*)(rowf + bj * 128)); __builtin_nontemporal_store(v1, (f32x4*)(rowf + bj * 128 + 4));
                        u32x4 w; w.x = cvt_pk_bf16(v0[0], v0[1]); w.y = cvt_pk_bf16(v0[2], v0[3]); w.z = cvt_pk_bf16(v1[0], v1[1]); w.w = cvt_pk_bf16(v1[2], v1[3]); *(u32x4*)(rowp + bj * 128) = w; } }
        } else if (pn < 13) {
            const int cb = (pn - 6) * 256 + colt;
#pragma unroll
            for (int ai = 0; ai < 2; ++ai)
#pragma unroll
                for (int m = 0; m < 4; ++m) { const int r = row0 + ai * 128 + m * 16; bf16_t* rowp = PR + (size_t)r * RWC + cb;
                    const bool last = smp ? (((r - MP) & 15) == 15) : ((r & 2047) == 2047);
                    float* rowf = out + (smp ? O_RSHS + (size_t)((r - MP) >> 4) * RWC : O_RSHP + (size_t)(r >> 11) * RWC) + cb;
#pragma unroll
                    for (int bj = 0; bj < 2; ++bj) { const f32x4 v0 = acc[ai][bj][m][0], v1 = acc[ai][bj][m][1]; if (last) { *(f32x4*)(rowf + bj * 128) = v0; *(f32x4*)(rowf + bj * 128 + 4) = v1; }
                        u32x4 w; w.x = cvt_pk_bf16(v0[0], v0[1]); w.y = cvt_pk_bf16(v0[2], v0[3]); w.z = cvt_pk_bf16(v1[0], v1[1]); w.w = cvt_pk_bf16(v1[2], v1[3]); *(u32x4*)(rowp + bj * 128) = w; } }
        } else {
            if (wc == 0 && fq == 0) {
                const f32x4 b0 = *(const f32x4*)bf, b1 = *(const f32x4*)(bf + 4);
#pragma unroll
                for (int ai = 0; ai < 2; ++ai)
#pragma unroll
                    for (int m = 0; m < 4; ++m) { const int r = row0 + ai * 128 + m * 16; const f32x4 v0 = acc[ai][0][m][0] + b0, v1 = acc[ai][0][m][1] + b1;
                        f32x4 l0, l1;
#pragma unroll
                        for (int j = 0; j < 4; ++j) { l0[j] = log_sigmoid_(v0[j]); l1[j] = log_sigmoid_(v1[j]); }
                        float* dst = out + (smp ? O_FLS + (size_t)(r - MP) * 8 : O_FLP + (size_t)r * 8);
                        *(f32x4*)dst = l0; *(f32x4*)(dst + 4) = l1; }
            }
        }
    }
};
struct EpiGelu {
    static constexpr bool PERM = true, AFTER_DRAIN = false;
    bf16_t* U; bf16_t* VR;
    __device__ __forceinline__ void operator()(const f32x4 (&acc)[2][2][4][2], const pg8::Unit& u, int wr, int wc, int fr, int fq) const {
        const int row0 = u.pm * 256 + wr * 64 + fr, pn = u.pn, cb = (pn & 3) * 256 + wc * 32 + 8 * fq;
#pragma unroll
        for (int ai = 0; ai < 2; ++ai)
#pragma unroll
            for (int m = 0; m < 4; ++m) { const size_t r = (size_t)(row0 + ai * 128 + m * 16);
#pragma unroll
                for (int bj = 0; bj < 2; ++bj) { const f32x4 v0 = acc[ai][bj][m][0], v1 = acc[ai][bj][m][1];
                    const f32x2 g0 = pg8::gelu_pk((f32x2){v0[0], v0[1]}), g1 = pg8::gelu_pk((f32x2){v0[2], v0[3]}), g2 = pg8::gelu_pk((f32x2){v1[0], v1[1]}), g3 = pg8::gelu_pk((f32x2){v1[2], v1[3]});
                    const int c = cb + bj * 128;
                    u32x4 w; w.x = cvt_pk_bf16(g0.x, g0.y); w.y = cvt_pk_bf16(g1.x, g1.y); w.z = cvt_pk_bf16(g2.x, g2.y); w.w = cvt_pk_bf16(g3.x, g3.y);
                    *(u32x4*)((pn < 4 ? U : VR) + r * DM + c) = w; } }
    }
};
struct SrcIdent { __device__ __forceinline__ int operator()(int c) const { return c; } };
struct SrcFfnIn { __device__ __forceinline__ int operator()(int c) const { return ((c >> 7) & 1) * DFF + (c >> 8) * 128 + (c & 127); } };
struct SrcEvenIn { __device__ __forceinline__ int operator()(int c) const { return c < 1536 ? c : (c < 3328 ? c + 8 : (c < 3336 ? c - 3328 + 1536 : -1)); } };
template <class Src> __device__ __forceinline__ void transpose_job(const float* W, int K, int ldw, bf16_t* WT, int Nout, const Src src, LAS float* scr, int gw, int NGW, int lane) {
    const int nblk = Nout / 32, nitems = (K / 64) * nblk;
    for (int it = gw; it < nitems; it += NGW) {
        const int kb = it / nblk, nb = it % nblk, k0 = 64 * kb, n0 = 32 * nb; const int sc = src(n0 + (lane & 31));
        float wv[32];
#pragma unroll
        for (int i = 0; i < 32; ++i) { const int kk = 2 * i + (lane >> 5); wv[i] = sc >= 0 ? __builtin_nontemporal_load(W + (size_t)(k0 + kk) * ldw + sc) : 0.f; }
#pragma unroll
        for (int i = 0; i < 32; ++i) { const int kk = 2 * i + (lane >> 5); scr[kk * 33 + (lane & 31)] = wv[i]; }
        LDS_WAIT();
        const int c = lane & 7;
#pragma unroll
        for (int j = 0; j < 4; ++j) { const int n = (lane >> 3) + 8 * j; const LAS float* s = scr + (8 * c) * 33 + n;
            u32x4 o; o.x = cvt_pk_bf16(s[0 * 33], s[1 * 33]); o.y = cvt_pk_bf16(s[2 * 33], s[3 * 33]); o.z = cvt_pk_bf16(s[4 * 33], s[5 * 33]); o.w = cvt_pk_bf16(s[6 * 33], s[7 * 33]);
            *(u32x4*)(WT + (size_t)(n0 + n) * K + k0 + 8 * c) = o; }
        LDS_WAIT();
    }
}
struct RowRegs { f32x4 v[4]; u32x4 y[2]; };
__device__ __forceinline__ void rn_load(RowRegs& R, const float* base, const bf16_t* y, int lane) {
#pragma unroll
    for (int j = 0; j < 2; ++j) { R.v[2 * j] = __builtin_nontemporal_load((const f32x4*)(base + 512 * j + 8 * lane)); R.v[2 * j + 1] = __builtin_nontemporal_load((const f32x4*)(base + 512 * j + 8 * lane + 4)); if (y) R.y[j] = __builtin_nontemporal_load((const u32x4*)(y + 512 * j + 8 * lane)); }
}
__device__ __forceinline__ void rn_finish(RowRegs& R, bool hasy, const float* gpost, float scale, float* xo, const float* gpre, bf16_t* hn, int lane) {
    if (hasy) { f32x4 t[4]; float s = 0.f;
#pragma unroll
        for (int j = 0; j < 2; ++j) { const u32x4 w = R.y[j];
            t[2 * j] = (f32x4){bf2f(w.x & 0xffff), bf2f(w.x >> 16), bf2f(w.y & 0xffff), bf2f(w.y >> 16)}; t[2 * j + 1] = (f32x4){bf2f(w.z & 0xffff), bf2f(w.z >> 16), bf2f(w.w & 0xffff), bf2f(w.w >> 16)}; }
#pragma unroll
        for (int j = 0; j < 4; ++j) s += (t[j][0] * t[j][0] + t[j][1] * t[j][1]) + (t[j][2] * t[j][2] + t[j][3] * t[j][3]);
        const float rs = rsqrtf(wave_sum(s) * (1.f / DM) + 1e-6f) * scale;
#pragma unroll
        for (int j = 0; j < 4; ++j) { const f32x4 g = *(const f32x4*)(gpost + 512 * (j >> 1) + 8 * lane + 4 * (j & 1)); R.v[j] = R.v[j] + t[j] * g * rs; } }
    if (xo) {
#pragma unroll
        for (int j = 0; j < 4; ++j) __builtin_nontemporal_store(R.v[j], (f32x4*)(xo + 512 * (j >> 1) + 8 * lane + 4 * (j & 1))); }
    if (hn) { float s = 0.f;
#pragma unroll
        for (int j = 0; j < 4; ++j) s += (R.v[j][0] * R.v[j][0] + R.v[j][1] * R.v[j][1]) + (R.v[j][2] * R.v[j][2] + R.v[j][3] * R.v[j][3]);
        const float rs = rsqrtf(wave_sum(s) * (1.f / DM) + 1e-6f);
#pragma unroll
        for (int j = 0; j < 2; ++j) { const f32x4 g0 = *(const f32x4*)(gpre + 512 * j + 8 * lane), g1 = *(const f32x4*)(gpre + 512 * j + 8 * lane + 4); const f32x4 o0 = R.v[2 * j] * g0 * rs, o1 = R.v[2 * j + 1] * g1 * rs;
            u32x4 w; w.x = cvt_pk_bf16(o0[0], o0[1]); w.y = cvt_pk_bf16(o0[2], o0[3]); w.z = cvt_pk_bf16(o1[0], o1[1]); w.w = cvt_pk_bf16(o1[2], o1[3]); *(u32x4*)(hn + 512 * j + 8 * lane) = w; } }
}
__device__ __forceinline__ void phase_prologue(ArgsK& a, LAS unsigned char* lds, int gw, int NGW, int wave, int lane) {
    unsigned char* ws = a.ws;
    LAS float* scr = (LAS float*)(lds + wave * 8448);
    for (int i = 0; i < 4; ++i) transpose_job(a.in[8] + (size_t)i * DM * 2 * DFF, DM, 2 * DFF, (bf16_t*)(ws + WS_WFI) + (size_t)i * 2 * DFF * DM, 2 * DFF, SrcFfnIn(), scr, gw, NGW, lane);
    for (int i = 0; i < 4; ++i) transpose_job(a.in[9] + (size_t)i * DFF * DM, DFF, DM, (bf16_t*)(ws + WS_WFO) + (size_t)i * DM * DFF, DM, SrcIdent(), scr, gw, NGW, lane);
    transpose_job(a.in[10], DM, 3336, (bf16_t*)(ws + WS_WEI), NEI, SrcEvenIn(), scr, gw, NGW, lane);
    transpose_job(a.in[23], DM, DM, (bf16_t*)(ws + WS_WEO), DM, SrcIdent(), scr, gw, NGW, lane);
    transpose_job(a.in[24], DM, 2 * DM, (bf16_t*)(ws + WS_WGI), 2 * DM, SrcIdent(), scr, gw, NGW, lane);
    transpose_job(a.in[29], DM, DM, (bf16_t*)(ws + WS_WGO), DM, SrcIdent(), scr, gw, NGW, lane);
    const int gt = gw * 64 + lane, NGT = NGW * 64;
    { bf16_t* WL = (bf16_t*)(ws + WS_WLO);
      for (int i = gt; i < 1536 * 256; i += NGT) { const int n = i >> 8, k = i & 255; float v = 0.f;
          if (n < 512) { if (k < 64) v = a.in[14][k * 512 + n]; } else if (n < 1024) { if (k >= 64 && k < 128) v = a.in[16][(k - 64) * 512 + n - 512]; } else { if (k >= 128) v = a.in[17][(k - 128) * 512 + n - 1024]; }
          WL[i] = (bf16_t)(cvt_pk_bf16(v, 0.f) & 0xffffu); } }
    { bf16_t* WS_ = (bf16_t*)(ws + WS_WSM);
      for (int i = gt; i < 8 * 128 * 128; i += NGT) { const int t = (i >> 7) & 127, s = i & 127; const float v = ((s >> 6) <= (t >> 6)) ? a.in[27][i] : 0.f; WS_[i] = (bf16_t)(cvt_pk_bf16(v, 0.f) & 0xffffu); } }
    for (int m = gw; m < M; m += 2 * NGW) { const int m2 = m + NGW; const bool two = m2 < M;
        const float* x0 = m < MP ? a.in[0] + (size_t)m * DM : a.in[1] + (size_t)(m - MP) * DM; const float* x1 = m2 < MP ? a.in[0] + (size_t)m2 * DM : a.in[1] + (size_t)(m2 - MP) * DM;
        RowRegs R0, R1; rn_load(R0, x0, nullptr, lane); if (two) rn_load(R1, x1, nullptr, lane);
        rn_finish(R0, false, nullptr, 0.f, nullptr, a.in[7], (bf16_t*)(ws + WS_HN) + (size_t)m * DM, lane);
        if (two) rn_finish(R1, false, nullptr, 0.f, nullptr, a.in[7], (bf16_t*)(ws + WS_HN) + (size_t)m2 * DM, lane); }
}
__device__ __forceinline__ void phase_rownorm(ArgsK& a, int idx, int bid, int G, int tid, int wave, int lane, unsigned* cnt) {
    const int layer = idx / 3, k = idx % 3; const float* ng = a.in[7] + (size_t)layer * 6 * DM;
    const float* gpost = ng + (2 * k + 1) * DM; const float scale = (k == 1) ? 1.0f : 0.5f;
    const float* gpre = (k < 2) ? ng + (2 * k + 2) * DM : (layer == 0 ? a.in[7] + 6 * DM : nullptr);
    float* X = a.out; const bf16_t* Y = (const bf16_t*)(a.ws + WS_Y); bf16_t* HN = (bf16_t*)(a.ws + WS_HN);
    if (bid < N_TAIL) return;
    const int gw = (bid - N_TAIL) * 8 + wave, NGW = (G - N_TAIL) * 8;
    for (int m = gw; m < MP; m += 2 * NGW) {
        const int m2 = m + NGW; const bool two = m2 < MP;
        const float* b0 = (idx == 0) ? a.in[0] + (size_t)m * DM : X + (size_t)m * DM;
        const float* b1 = (idx == 0) ? a.in[0] + (size_t)m2 * DM : X + (size_t)m2 * DM;
        RowRegs R0, R1; rn_load(R0, b0, Y + (size_t)m * DM, lane); if (two) rn_load(R1, b1, Y + (size_t)m2 * DM, lane);
        rn_finish(R0, true, gpost, scale, X + (size_t)m * DM, gpre, gpre ? HN + (size_t)m * DM : nullptr, lane);
        if (two) rn_finish(R1, true, gpost, scale, X + (size_t)m2 * DM, gpre, gpre ? HN + (size_t)m2 * DM : nullptr, lane); }
    if (bid < N_TAIL + 32) {
        if (tid == 0) { unsigned sp = 0u; while (__hip_atomic_load(cnt, __ATOMIC_RELAXED, __HIP_MEMORY_SCOPE_AGENT) < (unsigned)N_TAIL && ++sp < (1u << 22)) __builtin_amdgcn_s_sleep(2);
            __builtin_amdgcn_fence(__ATOMIC_ACQUIRE, "agent"); asm volatile("s_waitcnt vmcnt(0)" ::: "memory"); }
        __syncthreads();
        const int m = MP + (bid - N_TAIL) * 16 + wave * 2, m2 = m + 1;
        const float* b0 = (idx == 0) ? a.in[1] + (size_t)(m - MP) * DM : X + (size_t)m * DM;
        const float* b1 = (idx == 0) ? a.in[1] + (size_t)(m2 - MP) * DM : X + (size_t)m2 * DM;
        RowRegs R0, R1; rn_load(R0, b0, Y + (size_t)m * DM, lane); rn_load(R1, b1, Y + (size_t)m2 * DM, lane);
        rn_finish(R0, true, gpost, scale, X + (size_t)m * DM, gpre, gpre ? HN + (size_t)m * DM : nullptr, lane);
        rn_finish(R1, true, gpost, scale, X + (size_t)m2 * DM, gpre, gpre ? HN + (size_t)m2 * DM : nullptr, lane); }
}
struct TailOrder : pg8::StaticOrder {
    int tmode, tbid;
    __device__ __forceinline__ bool next(int i, pg8::Unit& u) const {
        if (tmode == 0) return pg8::StaticOrder::next(i, u);
        if (i > 0 || tbid >= N_TAIL) return false;
        u.pm = 256 + (tbid >> 2); u.pn = tbid & 3; return true; }
};
__device__ __forceinline__ void phase_prep(ArgsK& a, int gw, int NGW, int lane) {
    const bf16_t* PR = (const bf16_t*)(a.ws + WS_PR); bf16_t* LA = (bf16_t*)(a.ws + WS_LA);
    const f32x4 mu = *(const f32x4*)(a.in[12] + 1536 + 4 * lane);
    for (int m0 = gw; m0 < M; m0 += 4 * NGW) {
        u32x2 cw[4], pw[4]; f32x4 pf[4]; int tt[4];
#pragma unroll
        for (int q = 0; q < 4; ++q) { const int m = m0 + q * NGW; cw[q] = (u32x2){0u, 0u}; pw[q] = (u32x2){0u, 0u}; pf[q] = (f32x4){0.f, 0.f, 0.f, 0.f}; tt[q] = -1;
            if (m < M) { const bool smp = m >= MP; const int t = smp ? ((m - MP) & 15) : (m & 2047); tt[q] = t;
                cw[q] = *(const u32x2*)(PR + (size_t)m * RWC + 1536 + 4 * lane);
                if (t > 0) pw[q] = *(const u32x2*)(PR + (size_t)(m - 1) * RWC + 1536 + 4 * lane);
                else if (smp) pf[q] = *(const f32x4*)(a.in[6] + (size_t)((m - MP) >> 4) * RWC + 1536 + 4 * lane); } }
#pragma unroll
        for (int q = 0; q < 4; ++q) { const int m = m0 + q * NGW; if (m < M) {
            const f32x4 cur = (f32x4){bf2f(cw[q].x & 0xffff), bf2f(cw[q].x >> 16), bf2f(cw[q].y & 0xffff), bf2f(cw[q].y >> 16)};
            const f32x4 prev = (tt[q] > 0) ? (f32x4){bf2f(pw[q].x & 0xffff), bf2f(pw[q].x >> 16), bf2f(pw[q].y & 0xffff), bf2f(pw[q].y >> 16)} : pf[q];
            f32x4 xm = cur + (prev - cur) * mu;
            if (lane < 16) {
#pragma unroll
                for (int j = 0; j < 4; ++j) xm[j] = tanhf(xm[j]); }
            else if (lane >= 32) {
#pragma unroll
                for (int j = 0; j < 4; ++j) xm[j] = sigmoidf_(xm[j]); }
            u32x2 w; w.x = cvt_pk_bf16(xm[0], xm[1]); w.y = cvt_pk_bf16(xm[2], xm[3]); *(u32x2*)(LA + (size_t)m * 256 + 4 * lane) = w; } }
    }
    for (int sq = gw; sq < 512; sq += NGW) {
        const bool smp = sq >= 256; const int bh = sq & 255, b = bh >> 3, h = bh & 7;
        const float* src = smp ? a.in[4] + ((size_t)b * PASTL) * 8 + h : a.out + O_FLP + ((size_t)b * SEQ) * 8 + h;
        float* dst = smp ? (float*)(a.ws + WS_CUMS) + ((size_t)b * CTOT) * 8 + h : (float*)(a.ws + WS_CUMP) + ((size_t)b * SEQ) * 8 + h;
        float tot = 0.f;
        for (int i = 0; i < 32; ++i) tot += src[(size_t)(lane * 32 + i) * 8];
        float inc = tot;
#pragma unroll
        for (int o = 1; o < 64; o <<= 1) { const float nb = __shfl_up(inc, o); if (lane >= o) inc += nb; }
        float run = inc - tot;
        for (int i = 0; i < 32; ++i) { run += src[(size_t)(lane * 32 + i) * 8]; dst[(size_t)(lane * 32 + i) * 8] = run; }
        if (smp) { float endv = __shfl(inc, 63);
            if (lane == 0) { const float* nsrc = a.out + O_FLS + ((size_t)b * DSEQ) * 8 + h;
                for (int i = 0; i < DSEQ; ++i) { endv += nsrc[i * 8]; dst[(size_t)(PASTL + i) * 8] = endv; } } }
    }
}
struct ScanRaw { u32x4 cr, ck, cv, pr, pk, pv, aa, dd; };
__device__ __forceinline__ void unpack8(const u32x4& w, f32x4& lo, f32x4& hi) {
    lo = (f32x4){__uint_as_float(w.x << 16), __uint_as_float(w.x & 0xffff0000u), __uint_as_float(w.y << 16), __uint_as_float(w.y & 0xffff0000u)};
    hi = (f32x4){__uint_as_float(w.z << 16), __uint_as_float(w.z & 0xffff0000u), __uint_as_float(w.w << 16), __uint_as_float(w.w & 0xffff0000u)};
}
__device__ __forceinline__ u32x4 pack8u(const f32x4& lo, const f32x4& hi) { u32x4 w; w.x = cvt_pk_bf16(lo[0], lo[1]); w.y = cvt_pk_bf16(lo[2], lo[3]); w.z = cvt_pk_bf16(hi[0], hi[1]); w.w = cvt_pk_bf16(hi[2], hi[3]); return w; }
struct ScanOps { f32x4 a0, a1, w0, w1, b0, b1, k0, k1, r0, r1; float vi; };
#define F2LO(v) ((f32x2){(v)[0], (v)[1]})
#define F2HI(v) ((f32x2){(v)[2], (v)[3]})
constexpr int SC_T = 32, SC_ARR = SC_T * 64, SC_SET = 7 * SC_ARR;
__device__ __forceinline__ void scan_unit(ArgsK& a, LAS unsigned char* lds, int u, int tid, int wave, int lane) {
    const bool smp = u >= 256; const int bh = u & 255, b = bh >> 3, h = bh & 7;
    const int T = smp ? DSEQ : SEQ; const size_t row0 = smp ? (size_t)MP + b * DSEQ : (size_t)b * SEQ;
    const int NC = (T + SC_T - 1) / SC_T;
    LAS float* L0 = (LAS float*)lds;
    const bf16_t* PR = (const bf16_t*)(a.ws + WS_PR); const bf16_t* AA = (const bf16_t*)(a.ws + WS_AA); const bf16_t* GG = (const bf16_t*)(a.ws + WS_GG); const bf16_t* DEC = (const bf16_t*)(a.ws + WS_DEC);
    bf16_t* MIX = (bf16_t*)(a.ws + WS_MIX);
    const bool scanw = wave < 4;
    const int si = (wave & 3) * 8 + (lane >> 3), c8 = (lane & 7) * 8, hc = h * 64 + c8;
    f32x2 sA[4], sB[4];
    if (smp && scanw) { const float* sp = a.in[5] + (((size_t)bh * 64) + 2 * si) * 64 + c8; const f32x4 x0 = *(const f32x4*)sp, x1 = *(const f32x4*)(sp + 4), y0 = *(const f32x4*)(sp + 64), y1 = *(const f32x4*)(sp + 68);
        sA[0] = F2LO(x0); sA[1] = F2HI(x0); sA[2] = F2LO(x1); sA[3] = F2HI(x1); sB[0] = F2LO(y0); sB[1] = F2HI(y0); sB[2] = F2LO(y1); sB[3] = F2HI(y1); }
    else {
#pragma unroll
        for (int j = 0; j < 4; ++j) { sA[j] = (f32x2){0.f, 0.f}; sB[j] = (f32x2){0.f, 0.f}; } }
    ScanRaw raw; u32x4 ggw = (u32x4){0u, 0u, 0u, 0u};
#define SCAN_LOAD_RAW(t0_) do { const int t_ = (t0_) + si; const u32x4 z_ = (u32x4){0u, 0u, 0u, 0u}; \
        raw.cr = raw.ck = raw.cv = raw.pr = raw.pk = raw.pv = raw.aa = raw.dd = z_; \
        if (t_ < T) { const size_t m_ = row0 + t_; const bf16_t* p_ = PR + m_ * RWC + hc; \
            raw.cr = *(const u32x4*)p_; raw.ck = *(const u32x4*)(p_ + 512); raw.cv = *(const u32x4*)(p_ + 1024); \
            if (t_ > 0) { raw.pr = *(const u32x4*)(p_ - RWC); raw.pk = *(const u32x4*)(p_ - RWC + 512); raw.pv = *(const u32x4*)(p_ - RWC + 1024); } \
            else if (smp) { const float* sh_ = a.in[6] + (size_t)b * RWC + hc; raw.pr = pack8u(*(const f32x4*)sh_, *(const f32x4*)(sh_ + 4)); raw.pk = pack8u(*(const f32x4*)(sh_ + 512), *(const f32x4*)(sh_ + 516)); raw.pv = pack8u(*(const f32x4*)(sh_ + 1024), *(const f32x4*)(sh_ + 1028)); } \
            raw.aa = *(const u32x4*)(AA + m_ * 512 + hc); raw.dd = *(const u32x4*)(DEC + m_ * 512 + hc); } } while (0)
#define SCAN_PREP(S_) do { LAS float* B_ = L0 + (S_) * SC_SET; \
            f32x4 cl, ch, pl, ph, r0, r1, k0, k1, v0, v1, al, ah; \
            const f32x4 mr0 = *(const f32x4*)(a.in[12] + hc), mr1 = *(const f32x4*)(a.in[12] + hc + 4), mk0 = *(const f32x4*)(a.in[12] + 512 + hc), mk1 = *(const f32x4*)(a.in[12] + 512 + hc + 4), mv0 = *(const f32x4*)(a.in[12] + 1024 + hc), mv1 = *(const f32x4*)(a.in[12] + 1024 + hc + 4); \
            unpack8(raw.cr, cl, ch); unpack8(raw.pr, pl, ph); r0 = cl + (pl - cl) * mr0; r1 = ch + (ph - ch) * mr1; \
            unpack8(raw.ck, cl, ch); unpack8(raw.pk, pl, ph); k0 = cl + (pl - cl) * mk0; k1 = ch + (ph - ch) * mk1; \
            unpack8(raw.cv, cl, ch); unpack8(raw.pv, pl, ph); v0 = cl + (pl - cl) * mv0; v1 = ch + (ph - ch) * mv1; \
            unpack8(raw.aa, al, ah); \
            const f32x4 kw0 = *(const f32x4*)(a.in[18] + hc), kw1 = *(const f32x4*)(a.in[18] + hc + 4), ka0 = *(const f32x4*)(a.in[19] + hc), ka1 = *(const f32x4*)(a.in[19] + hc + 4); \
            f32x4 q0 = k0 * kw0, q1 = k1 * kw1; \
            const float n2 = red8((q0[0] * q0[0] + q0[1] * q0[1]) + (q0[2] * q0[2] + q0[3] * q0[3]) + ((q1[0] * q1[0] + q1[1] * q1[1]) + (q1[2] * q1[2] + q1[3] * q1[3]))); \
            const float inv = 1.0f / fmaxf(sqrtf(n2), 1e-12f); \
            q0 = q0 * inv; q1 = q1 * inv; \
            const f32x4 km0 = k0 * (1.0f + (al - 1.0f) * ka0), km1 = k1 * (1.0f + (ah - 1.0f) * ka1); \
            const int o = si * 64 + c8; \
            *(LAS f32x4*)(B_ + o) = r0; *(LAS f32x4*)(B_ + o + 4) = r1; { f32x4 dl_, dh_; unpack8(raw.dd, dl_, dh_); \
              _Pragma("unroll") for (int j_ = 0; j_ < 4; ++j_) { dl_[j_] = __builtin_amdgcn_exp2f(-0.6065306597f * LOG2E * dl_[j_]); dh_[j_] = __builtin_amdgcn_exp2f(-0.6065306597f * LOG2E * dh_[j_]); } \
              *(LAS f32x4*)(B_ + SC_ARR + o) = dl_; *(LAS f32x4*)(B_ + SC_ARR + o + 4) = dh_; } \
            *(LAS f32x4*)(B_ + 2 * SC_ARR + o) = km0; *(LAS f32x4*)(B_ + 2 * SC_ARR + o + 4) = km1; *(LAS f32x4*)(B_ + 3 * SC_ARR + o) = v0; *(LAS f32x4*)(B_ + 3 * SC_ARR + o + 4) = v1; \
            *(LAS f32x4*)(B_ + 4 * SC_ARR + o) = -q0; *(LAS f32x4*)(B_ + 4 * SC_ARR + o + 4) = -q1; *(LAS f32x4*)(B_ + 5 * SC_ARR + o) = q0 * al; *(LAS f32x4*)(B_ + 5 * SC_ARR + o + 4) = q1 * ah; } while (0)
#define SCAN_POST(S_, t0_) do { if ((t0_) + si < T) { const LAS float* B_ = L0 + (S_) * SC_SET; const int o = si * 64 + c8; const size_t m = row0 + (t0_) + si; \
            const f32x4 y0 = *(const LAS f32x4*)(B_ + 6 * SC_ARR + o), y1 = *(const LAS f32x4*)(B_ + 6 * SC_ARR + o + 4); \
            const float mean = red8((y0[0] + y0[1]) + (y0[2] + y0[3]) + ((y1[0] + y1[1]) + (y1[2] + y1[3]))) * (1.f / 64.f); \
            const f32x4 d0 = y0 - mean, d1 = y1 - mean; \
            const float var = red8((d0[0] * d0[0] + d0[1] * d0[1]) + (d0[2] * d0[2] + d0[3] * d0[3]) + ((d1[0] * d1[0] + d1[1] * d1[1]) + (d1[2] * d1[2] + d1[3] * d1[3]))) * (1.f / 64.f); \
            const float rstd = rsqrtf(var + 64e-5f); \
            const f32x4 r0 = *(const LAS f32x4*)(B_ + o), r1 = *(const LAS f32x4*)(B_ + o + 4), k0 = *(const LAS f32x4*)(B_ + 2 * SC_ARR + o), k1 = *(const LAS f32x4*)(B_ + 2 * SC_ARR + o + 4), v0 = *(const LAS f32x4*)(B_ + 3 * SC_ARR + o), v1 = *(const LAS f32x4*)(B_ + 3 * SC_ARR + o + 4); \
            const f32x4 rk0 = *(const f32x4*)(a.in[20] + hc), rk1 = *(const f32x4*)(a.in[20] + hc + 4); \
            const f32x4 e0 = r0 * k0 * rk0, e1 = r1 * k1 * rk1; \
            const float bon = red8((e0[0] + e0[1]) + (e0[2] + e0[3]) + ((e1[0] + e1[1]) + (e1[2] + e1[3]))); \
            f32x4 gl, gh; unpack8(ggw, gl, gh); \
            const f32x4 o0 = (d0 * rstd * *(const f32x4*)(a.in[21] + hc) + *(const f32x4*)(a.in[22] + hc) + v0 * bon) * gl; \
            const f32x4 o1 = (d1 * rstd * *(const f32x4*)(a.in[21] + hc + 4) + *(const f32x4*)(a.in[22] + hc + 4) + v1 * bon) * gh; \
            *(u32x4*)(MIX + m * DM + 512 + hc) = pack8u(o0, o1); } } while (0)
#define SCAN_LD(O, V2, B_, tt_) do { const int o_ = (tt_) * 64 + c8; O.a0 = *(const LAS f32x4*)(B_ + 4 * SC_ARR + o_); O.a1 = *(const LAS f32x4*)(B_ + 4 * SC_ARR + o_ + 4); O.w0 = *(const LAS f32x4*)(B_ + SC_ARR + o_); O.w1 = *(const LAS f32x4*)(B_ + SC_ARR + o_ + 4); \
                O.b0 = *(const LAS f32x4*)(B_ + 5 * SC_ARR + o_); O.b1 = *(const LAS f32x4*)(B_ + 5 * SC_ARR + o_ + 4); O.k0 = *(const LAS f32x4*)(B_ + 2 * SC_ARR + o_); O.k1 = *(const LAS f32x4*)(B_ + 2 * SC_ARR + o_ + 4); \
                O.r0 = *(const LAS f32x4*)(B_ + o_); O.r1 = *(const LAS f32x4*)(B_ + o_ + 4); V2 = *(const LAS f32x2*)(B_ + 3 * SC_ARR + (tt_) * 64 + 2 * si); } while (0)
#define SCAN_STEP(O, V2, B_, tt_) do { \
                const f32x2 a01 = F2LO(O.a0), a23 = F2HI(O.a0), a45 = F2LO(O.a1), a67 = F2HI(O.a1); \
                f32x2 pA = sA[0] * a01, pB = sB[0] * a01; pA = sA[1] * a23 + pA; pB = sB[1] * a23 + pB; pA = sA[2] * a45 + pA; pB = sB[2] * a45 + pB; pA = sA[3] * a67 + pA; pB = sB[3] * a67 + pB; \
                float saA = pA[0] + pA[1], saB = pB[0] + pB[1]; \
                saA += dppf<0xB1>(saA); saB += dppf<0xB1>(saB); saA += dppf<0x4E>(saA); saB += dppf<0x4E>(saB); saA += dppf<0x141>(saA); saB += dppf<0x141>(saB); \
                const f32x2 svA = (f32x2){saA, saA}, svB = (f32x2){saB, saB}, vvA = (f32x2){V2[0], V2[0]}, vvB = (f32x2){V2[1], V2[1]}; \
                { const f32x2 w = F2LO(O.w0), bb = F2LO(O.b0), kk = F2LO(O.k0); sA[0] = sA[0] * w + (svA * bb + vvA * kk); sB[0] = sB[0] * w + (svB * bb + vvB * kk); } \
                { const f32x2 w = F2HI(O.w0), bb = F2HI(O.b0), kk = F2HI(O.k0); sA[1] = sA[1] * w + (svA * bb + vvA * kk); sB[1] = sB[1] * w + (svB * bb + vvB * kk); } \
                { const f32x2 w = F2LO(O.w1), bb = F2LO(O.b1), kk = F2LO(O.k1); sA[2] = sA[2] * w + (svA * bb + vvA * kk); sB[2] = sB[2] * w + (svB * bb + vvB * kk); } \
                { const f32x2 w = F2HI(O.w1), bb = F2HI(O.b1), kk = F2HI(O.k1); sA[3] = sA[3] * w + (svA * bb + vvA * kk); sB[3] = sB[3] * w + (svB * bb + vvB * kk); } \
                const f32x2 r01 = F2LO(O.r0), r23 = F2HI(O.r0), r45 = F2LO(O.r1), r67 = F2HI(O.r1); \
                f32x2 qA = sA[0] * r01, qB = sB[0] * r01; qA = sA[1] * r23 + qA; qB = sB[1] * r23 + qB; qA = sA[2] * r45 + qA; qB = sB[2] * r45 + qB; qA = sA[3] * r67 + qA; qB = sB[3] * r67 + qB; \
                float yA = qA[0] + qA[1], yB = qB[0] + qB[1]; \
                yA += dppf<0xB1>(yA); yB += dppf<0xB1>(yB); yA += dppf<0x4E>(yA); yB += dppf<0x4E>(yB); yA += dppf<0x141>(yA); yB += dppf<0x141>(yB); \
                *(LAS f32x2*)(B_ + 6 * SC_ARR + (tt_) * 64 + 2 * si) = (f32x2){yA, yB}; } while (0)
    if (!scanw) { SCAN_LOAD_RAW(0); SCAN_PREP(0); if (SC_T < T) SCAN_LOAD_RAW(SC_T); }
    __syncthreads();
    for (int c = 0; c < NC; ++c) {
        const int t0 = c * SC_T, nt = (T - t0) < SC_T ? (T - t0) : SC_T;
        if (scanw) {
            LAS float* Bc = L0 + (c & 1) * SC_SET;
            ScanOps oA, oB; f32x2 vA2, vB2;
            SCAN_LD(oA, vA2, Bc, 0);
            for (int tt = 0; tt < nt; tt += 2) {
                SCAN_LD(oB, vB2, Bc, tt + 1);
                SCAN_STEP(oA, vA2, Bc, tt);
                { const int tn = (tt + 2 < nt) ? tt + 2 : tt; SCAN_LD(oA, vA2, Bc, tn); }
                SCAN_STEP(oB, vB2, Bc, tt + 1);
            }
        } else {
            if (c >= 1) SCAN_POST((c - 1) & 1, t0 - SC_T);
            if (t0 + si < T) ggw = *(const u32x4*)(GG + (row0 + t0 + si) * 512 + hc);
            if (c + 1 < NC) { SCAN_PREP((c + 1) & 1); if (t0 + 2 * SC_T < T) SCAN_LOAD_RAW(t0 + 2 * SC_T); }
        }
        __syncthreads();
    }
    if (!scanw) SCAN_POST((NC - 1) & 1, (NC - 1) * SC_T);
    __syncthreads();
#undef SCAN_LOAD_RAW
#undef SCAN_PREP
#undef SCAN_POST
#undef SCAN_LD
#undef SCAN_STEP
    if (scanw) { float* so = a.out + (smp ? O_RSS : O_RSP) + (((size_t)bh * 64) + 2 * si) * 64 + c8;
      *(f32x4*)so = (f32x4){sA[0][0], sA[0][1], sA[1][0], sA[1][1]}; *(f32x4*)(so + 4) = (f32x4){sA[2][0], sA[2][1], sA[3][0], sA[3][1]};
      *(f32x4*)(so + 64) = (f32x4){sB[0][0], sB[0][1], sB[1][0], sB[1][1]}; *(f32x4*)(so + 68) = (f32x4){sB[2][0], sB[2][1], sB[3][0], sB[3][1]}; }
}
#define MFMA16(a_, b_, c_) __builtin_amdgcn_mfma_f32_16x16x32_bf16((a_), (b_), (c_), 0, 0, 0)
__device__ __forceinline__ s16x4 tr_read(LAS unsigned char* p) { return __builtin_bit_cast(s16x4, __builtin_amdgcn_ds_read_tr16_b64_v4i16((LAS v4i16_t*)p)); }
__device__ __forceinline__ bf16x8 pack8(const f32x4& lo, const f32x4& hi) { u32x4 w; w.x = cvt_pk_bf16(lo[0], lo[1]); w.y = cvt_pk_bf16(lo[2], lo[3]); w.z = cvt_pk_bf16(hi[0], hi[1]); w.w = cvt_pk_bf16(hi[2], hi[3]); return __builtin_bit_cast(bf16x8, w); }
constexpr int AT_K = 0, AT_V = 9216, AT_CK = 9216 + 10240, AT_BUF = 19712;
__device__ __forceinline__ float xmax16_32(float v) {
    { const auto r = __builtin_amdgcn_permlane16_swap(__float_as_uint(v), __float_as_uint(v), false, false); v = fmaxf(__uint_as_float(r[0]), __uint_as_float(r[1])); }
    { const auto r = __builtin_amdgcn_permlane32_swap(__float_as_uint(v), __float_as_uint(v), false, false); v = fmaxf(__uint_as_float(r[0]), __uint_as_float(r[1])); }
    return v;
}
__device__ __forceinline__ float xsum16_32(float v) {
    { const auto r = __builtin_amdgcn_permlane16_swap(__float_as_uint(v), __float_as_uint(v), false, false); v = __uint_as_float(r[0]) + __uint_as_float(r[1]); }
    { const auto r = __builtin_amdgcn_permlane32_swap(__float_as_uint(v), __float_as_uint(v), false, false); v = __uint_as_float(r[0]) + __uint_as_float(r[1]); }
    return v;
}
__device__ __forceinline__ void attn_prompt_unit(ArgsK& a, LAS unsigned char* lds, int b, int h, int qb, int tid, int wave, int lane) {
    const int l15 = lane & 15, quad = lane >> 4;
    const bf16_t* QB = (const bf16_t*)(a.ws + WS_QB); const bf16_t* KB = (const bf16_t*)(a.ws + WS_KB); const bf16_t* VB = (const bf16_t*)(a.ws + WS_VB);
    const float* CUM = (const float*)(a.ws + WS_CUMP); bf16_t* MIX = (bf16_t*)(a.ws + WS_MIX);
    const size_t rowb = (size_t)b * SEQ; const int q0 = qb * 256, qw = q0 + wave * 32;
    bf16x8 qf[2][2]; float cq[2];
#pragma unroll
    for (int qq = 0; qq < 2; ++qq) { const size_t r = rowb + qw + qq * 16 + l15; cq[qq] = CUM[r * 8 + h] * LOG2E;
#pragma unroll
        for (int ks = 0; ks < 2; ++ks) qf[qq][ks] = *(const bf16x8*)(QB + r * 512 + h * 64 + ks * 32 + quad * 8); }
    f32x4 o[2][4]; float mrun[2], lrun[2];
#pragma unroll
    for (int qq = 0; qq < 2; ++qq) { mrun[qq] = -INFINITY; lrun[qq] = 0.f;
#pragma unroll
        for (int d = 0; d < 4; ++d) o[qq][d] = (f32x4){0.f, 0.f, 0.f, 0.f}; }
    const int NT = (q0 + 256) / 64, skey = tid >> 3, sch = tid & 7;
    u32x4 kreg, vreg, kreg2 = (u32x4){0u, 0u, 0u, 0u}, vreg2 = (u32x4){0u, 0u, 0u, 0u}; float ckreg = 0.f, ckreg2 = 0.f;
    { const size_t r = rowb + skey; kreg = *(const u32x4*)(KB + r * 512 + h * 64 + sch * 8); vreg = *(const u32x4*)(VB + r * 512 + h * 64 + sch * 8); if (tid < 64) ckreg = CUM[(rowb + tid) * 8 + h] * LOG2E; }
    *(LAS u32x4*)(lds + AT_K + skey * 144 + sch * 16) = kreg; *(LAS u32x4*)(lds + AT_V + skey * 160 + sch * 16) = vreg; if (tid < 64) ((LAS float*)(lds + AT_CK))[tid] = ckreg;
    { const size_t r = rowb + 64 + skey; kreg = *(const u32x4*)(KB + r * 512 + h * 64 + sch * 8); vreg = *(const u32x4*)(VB + r * 512 + h * 64 + sch * 8); if (tid < 64) ckreg = CUM[(rowb + 64 + tid) * 8 + h] * LOG2E; }
    __syncthreads();
    for (int kt = 0; kt < NT; ++kt) {
        LAS unsigned char* bufc = lds + (kt & 1) * AT_BUF; LAS unsigned char* bufn = lds + ((kt + 1) & 1) * AT_BUF;
        const bool more = kt + 1 < NT;
        if (kt + 2 < NT) { const size_t r = rowb + (kt + 2) * 64 + skey; kreg2 = *(const u32x4*)(KB + r * 512 + h * 64 + sch * 8); vreg2 = *(const u32x4*)(VB + r * 512 + h * 64 + sch * 8);
            if (tid < 64) ckreg2 = CUM[(rowb + (kt + 2) * 64 + tid) * 8 + h] * LOG2E; }
        if (kt * 64 <= qw + 31) {
            const LAS float* CK = (const LAS float*)(bufc + AT_CK);
            f32x4 st[4][2];
#pragma unroll
            for (int kb = 0; kb < 4; ++kb) { const bf16x8 k0 = *(const LAS bf16x8*)(bufc + AT_K + (kb * 16 + l15) * 144 + quad * 16), k1 = *(const LAS bf16x8*)(bufc + AT_K + (kb * 16 + l15) * 144 + 64 + quad * 16);
                const f32x4 ckv = *(const LAS f32x4*)(CK + kb * 16 + quad * 4);
#pragma unroll
                for (int qq = 0; qq < 2; ++qq) { const f32x4 ci = (f32x4){cq[qq] - ckv[0], cq[qq] - ckv[1], cq[qq] - ckv[2], cq[qq] - ckv[3]};
                    st[kb][qq] = MFMA16(k0, qf[qq][0], ci); st[kb][qq] = MFMA16(k1, qf[qq][1], st[kb][qq]); } }
            if (kt * 64 + 63 > qw) {
#pragma unroll
                for (int kb = 0; kb < 4; ++kb)
#pragma unroll
                    for (int qq = 0; qq < 2; ++qq)
#pragma unroll
                        for (int j = 0; j < 4; ++j) if (kt * 64 + kb * 16 + quad * 4 + j > qw + qq * 16 + l15) st[kb][qq][j] = -INFINITY; }
#pragma unroll
            for (int qq = 0; qq < 2; ++qq) { float mx = fmaxf(fmaxf(st[0][qq][0], st[0][qq][1]), fmaxf(st[0][qq][2], st[0][qq][3]));
#pragma unroll
                for (int kb = 1; kb < 4; ++kb) mx = fmaxf(mx, fmaxf(fmaxf(st[kb][qq][0], st[kb][qq][1]), fmaxf(st[kb][qq][2], st[kb][qq][3])));
                mx = xmax16_32(mx);
                const float mnew = fmaxf(mrun[qq], mx), alpha = __builtin_amdgcn_exp2f(mrun[qq] - mnew); mrun[qq] = mnew; float ps = 0.f;
#pragma unroll
                for (int kb = 0; kb < 4; ++kb)
#pragma unroll
                    for (int j = 0; j < 4; ++j) { const float p = __builtin_amdgcn_exp2f(st[kb][qq][j] - mnew); st[kb][qq][j] = p; ps += p; }
                lrun[qq] = lrun[qq] * alpha + ps;
#pragma unroll
                for (int d = 0; d < 4; ++d) o[qq][d] = o[qq][d] * alpha; }
#pragma unroll
            for (int c = 0; c < 2; ++c) { bf16x8 pf[2];
#pragma unroll
                for (int qq = 0; qq < 2; ++qq) pf[qq] = pack8(st[2 * c][qq], st[2 * c + 1][qq]);
#pragma unroll
                for (int d = 0; d < 4; ++d) { LAS unsigned char* vp = bufc + AT_V + (32 * c + quad * 4 + (l15 >> 2)) * 160 + d * 32 + (lane & 3) * 8;
                    const s16x4 r1 = tr_read(vp), r2 = tr_read(vp + 16 * 160);
                    const bf16x8 vf = (bf16x8){r1[0], r1[1], r1[2], r1[3], r2[0], r2[1], r2[2], r2[3]};
#pragma unroll
                    for (int qq = 0; qq < 2; ++qq) o[qq][d] = MFMA16(vf, pf[qq], o[qq][d]); } }
        }
        if (more) { *(LAS u32x4*)(bufn + AT_K + skey * 144 + sch * 16) = kreg; *(LAS u32x4*)(bufn + AT_V + skey * 160 + sch * 16) = vreg; if (tid < 64) ((LAS float*)(bufn + AT_CK))[tid] = ckreg; }
        kreg = kreg2; vreg = vreg2; ckreg = ckreg2;
        __syncthreads();
    }
#pragma unroll
    for (int qq = 0; qq < 2; ++qq) { const float inv = 1.0f / xsum16_32(lrun[qq]);
        bf16_t* orow = MIX + (rowb + qw + qq * 16 + l15) * DM + h * 64 + quad * 4;
#pragma unroll
        for (int d = 0; d < 4; ++d) { const f32x4 v = o[qq][d] * inv; u32x2 w; w.x = cvt_pk_bf16(v[0], v[1]); w.y = cvt_pk_bf16(v[2], v[3]); *(u32x2*)(orow + d * 16) = w; } }
}
__device__ __forceinline__ bf16x8 ld8f(const float* p) { const f32x4 x = __builtin_nontemporal_load((const f32x4*)p), y = __builtin_nontemporal_load((const f32x4*)(p + 4)); return pack8(x, y); }
__device__ __forceinline__ void attn_sample_unit(ArgsK& a, LAS unsigned char* lds, int b, int h, int tid, int wave, int lane) {
    const int l15 = lane & 15, quad = lane >> 4;
    const bf16_t* QB = (const bf16_t*)(a.ws + WS_QB); const bf16_t* KB = (const bf16_t*)(a.ws + WS_KB); const bf16_t* VB = (const bf16_t*)(a.ws + WS_VB);
    const float* CUM = (const float*)(a.ws + WS_CUMS) + ((size_t)b * CTOT) * 8 + h; bf16_t* MIX = (bf16_t*)(a.ws + WS_MIX);
    const size_t rs = (size_t)MP + b * DSEQ;
    const float* ckb = a.in[2] + ((size_t)b * PASTL) * 512 + h * 64; const float* cvb = a.in[3] + ((size_t)b * PASTL) * 512 + h * 64;
    bf16x8 qf[2];
#pragma unroll
    for (int ks = 0; ks < 2; ++ks) qf[ks] = *(const bf16x8*)(QB + (rs + l15) * 512 + h * 64 + ks * 32 + quad * 8);
    const float cq = CUM[(size_t)(PASTL + l15) * 8] * LOG2E;
    f32x4 o[4]; float mrun = -INFINITY, lrun = 0.f;
#pragma unroll
    for (int d = 0; d < 4; ++d) o[d] = (f32x4){0.f, 0.f, 0.f, 0.f};
    const int nch = (wave == 0) ? 9 : 8;
    for (int ch = 0; ch < nch; ++ch) {
        const bool nw = (ch == 8); const int k0 = wave * 256 + ch * 32;
        f32x4 st[2];
        if (!nw) {
#pragma unroll
            for (int kb = 0; kb < 2; ++kb) { const float* kp = ckb + (size_t)(k0 + kb * 16 + l15) * 512 + quad * 8;
                st[kb] = MFMA16(ld8f(kp), qf[0], ((f32x4){0.f, 0.f, 0.f, 0.f})); st[kb] = MFMA16(ld8f(kp + 32), qf[1], st[kb]);
#pragma unroll
                for (int j = 0; j < 4; ++j) st[kb][j] += cq - CUM[(size_t)(k0 + kb * 16 + quad * 4 + j) * 8] * LOG2E; }
        } else {
            const bf16_t* kp = KB + (rs + l15) * 512 + h * 64 + quad * 8;
            st[0] = MFMA16(*(const bf16x8*)kp, qf[0], ((f32x4){0.f, 0.f, 0.f, 0.f})); st[0] = MFMA16(*(const bf16x8*)(kp + 32), qf[1], st[0]);
#pragma unroll
            for (int j = 0; j < 4; ++j) { float sv = st[0][j] + (cq - CUM[(size_t)(PASTL + quad * 4 + j) * 8] * LOG2E); if (quad * 4 + j > l15) sv = -INFINITY; st[0][j] = sv; st[1][j] = -INFINITY; }
        }
        float mx = fmaxf(fmaxf(fmaxf(st[0][0], st[0][1]), fmaxf(st[0][2], st[0][3])), fmaxf(fmaxf(st[1][0], st[1][1]), fmaxf(st[1][2], st[1][3])));
        mx = fmaxf(mx, __shfl_xor(mx, 16)); mx = fmaxf(mx, __shfl_xor(mx, 32));
        const float mnew = fmaxf(mrun, mx), alpha = __builtin_amdgcn_exp2f(mrun - mnew); mrun = mnew; float ps = 0.f;
#pragma unroll
        for (int kb = 0; kb < 2; ++kb)
#pragma unroll
            for (int j = 0; j < 4; ++j) { const float p = __builtin_amdgcn_exp2f(st[kb][j] - mnew); st[kb][j] = p; ps += p; }
        lrun = lrun * alpha + ps;
        const bf16x8 pf = pack8(st[0], st[1]);
#pragma unroll
        for (int d = 0; d < 4; ++d) { f32x4 lo, hi;
            if (!nw) { const float* vp = cvb + (size_t)(k0 + quad * 4) * 512 + d * 16 + l15;
#pragma unroll
                for (int j = 0; j < 4; ++j) { lo[j] = __builtin_nontemporal_load(vp + (size_t)j * 512); hi[j] = __builtin_nontemporal_load(vp + (size_t)(16 + j) * 512); } }
            else { const bf16_t* vp = VB + (rs + quad * 4) * 512 + h * 64 + d * 16 + l15;
#pragma unroll
                for (int j = 0; j < 4; ++j) { lo[j] = bf2f(vp[(size_t)j * 512]); hi[j] = 0.f; } }
            o[d] = MFMA16(pack8(lo, hi), pf, o[d] * alpha); }
    }
    lrun += __shfl_xor(lrun, 16); lrun += __shfl_xor(lrun, 32);
    LAS float* Ml = (LAS float*)lds; LAS float* Ll = Ml + 128; LAS float* Ol = Ll + 128;
    if (quad == 0) { Ml[wave * 16 + l15] = mrun; Ll[wave * 16 + l15] = lrun; }
#pragma unroll
    for (int d = 0; d < 4; ++d) *(LAS f32x4*)(Ol + (wave * 16 + l15) * 64 + d * 16 + quad * 4) = o[d];
    __syncthreads();
    { const int q = tid >> 5, d0 = (tid & 31) * 2; float mm = -INFINITY;
#pragma unroll
      for (int w = 0; w < 8; ++w) mm = fmaxf(mm, Ml[w * 16 + q]);
      float L = 0.f, x0 = 0.f, x1 = 0.f;
#pragma unroll
      for (int w = 0; w < 8; ++w) { const float f = __builtin_amdgcn_exp2f(Ml[w * 16 + q] - mm); L += Ll[w * 16 + q] * f; x0 += Ol[(w * 16 + q) * 64 + d0] * f; x1 += Ol[(w * 16 + q) * 64 + d0 + 1] * f; }
      const float inv = 1.0f / L;
      *(unsigned*)(MIX + (rs + q) * DM + h * 64 + d0) = cvt_pk_bf16(x0 * inv, x1 * inv); }
    __syncthreads();
}
constexpr int GT_ST = 0, GT_V = 1024, GT_VSTR = 288;
__device__ __forceinline__ void gate_prompt_unit(ArgsK& a, LAS unsigned char* lds, int n, int tid, int wave, int lane) {
    const int l15 = lane & 15, quad = lane >> 4; const size_t r0 = (size_t)n * 128;
    const bf16_t* VR = (const bf16_t*)(a.ws + WS_VR); const bf16_t* U = (const bf16_t*)(a.ws + WS_U); bf16_t* UG = (bf16_t*)(a.ws + WS_UG); const bf16_t* WSM = (const bf16_t*)(a.ws + WS_WSM);
    LAS float* ST = (LAS float*)(lds + GT_ST);
    for (int rr = 0; rr < 16; rr += 4) {
        f32x4 v[4][4];
#pragma unroll
        for (int q = 0; q < 4; ++q) { const bf16_t* vr = VR + (r0 + wave * 16 + rr + q) * DM;
#pragma unroll
            for (int j = 0; j < 4; ++j) v[q][j] = ({ const u32x2 w_ = ((const u32x2*)vr)[lane + 64 * j]; (f32x4){bf2f(w_.x & 0xffff), bf2f(w_.x >> 16), bf2f(w_.y & 0xffff), bf2f(w_.y >> 16)}; }); }
#pragma unroll
        for (int q = 0; q < 4; ++q) { float s = 0.f;
#pragma unroll
            for (int j = 0; j < 4; ++j) s += (v[q][j][0] + v[q][j][1]) + (v[q][j][2] + v[q][j][3]);
            const float mean = wave_sum(s) * (1.f / DM); float s2 = 0.f;
#pragma unroll
            for (int j = 0; j < 4; ++j) { const f32x4 d = v[q][j] - mean; s2 += (d[0] * d[0] + d[1] * d[1]) + (d[2] * d[2] + d[3] * d[3]); }
            const float rstd = rsqrtf(wave_sum(s2) * (1.f / DM) + 1e-5f);
            if (lane == 0) { ST[(wave * 16 + rr + q) * 2] = mean; ST[(wave * 16 + rr + q) * 2 + 1] = rstd; } } }
    __syncthreads();
    const int sch = tid & 31, srb = tid >> 5;
    const int t = wave * 16 + l15, nch = (wave < 4) ? 2 : 4;
    f32x4 xr[8];
#pragma unroll
    for (int i = 0; i < 8; ++i) xr[i] = ({ const u32x2 w_ = *(const u32x2*)(VR + (r0 + srb + 16 * i) * DM + sch * 4); (f32x4){bf2f(w_.x & 0xffff), bf2f(w_.x >> 16), bf2f(w_.y & 0xffff), bf2f(w_.y >> 16)}; });
    for (int g = 0; g < 8; ++g) {
        { const f32x4 lg = *(const f32x4*)(a.in[25] + g * 128 + sch * 4), lb = *(const f32x4*)(a.in[26] + g * 128 + sch * 4);
#pragma unroll
          for (int i = 0; i < 8; ++i) { const int row = srb + 16 * i; const float mean = ST[row * 2], rstd = ST[row * 2 + 1];
              const f32x4 x = (xr[i] - mean) * rstd * lg + lb; u32x2 w; w.x = cvt_pk_bf16(x[0], x[1]); w.y = cvt_pk_bf16(x[2], x[3]);
              *(LAS u32x2*)(lds + GT_V + row * GT_VSTR + sch * 8) = w; } }
        __syncthreads();
        if (g + 1 < 8) {
#pragma unroll
            for (int i = 0; i < 8; ++i) xr[i] = ({ const u32x2 w_ = __builtin_nontemporal_load((const u32x2*)(VR + (r0 + srb + 16 * i) * DM + (g + 1) * 128 + sch * 4)); (f32x4){bf2f(w_.x & 0xffff), bf2f(w_.x >> 16), bf2f(w_.y & 0xffff), bf2f(w_.y >> 16)}; }); }
        u32x2 uw[8];
#pragma unroll
        for (int cb = 0; cb < 8; ++cb) uw[cb] = __builtin_nontemporal_load((const u32x2*)(U + (r0 + t) * DM + g * 128 + cb * 16 + quad * 4));
        f32x4 acc[8];
#pragma unroll
        for (int cb = 0; cb < 8; ++cb) acc[cb] = (f32x4){0.f, 0.f, 0.f, 0.f};
        for (int c = 0; c < nch; ++c) { const bf16_t* wp = WSM + ((size_t)(g * 128 + t)) * 128 + 32 * c + quad * 4;
            const u32x2 w1 = *(const u32x2*)wp, w2 = *(const u32x2*)(wp + 16); const bf16x8 wf = __builtin_bit_cast(bf16x8, ((u32x4){w1.x, w1.y, w2.x, w2.y}));
#pragma unroll
            for (int cb = 0; cb < 8; ++cb) { LAS unsigned char* vp = lds + GT_V + (32 * c + quad * 4 + (l15 >> 2)) * GT_VSTR + cb * 32 + (lane & 3) * 8;
                const s16x4 r1 = tr_read(vp), r2 = tr_read(vp + 16 * GT_VSTR);
                acc[cb] = MFMA16(((bf16x8){r1[0], r1[1], r1[2], r1[3], r2[0], r2[1], r2[2], r2[3]}), wf, acc[cb]); } }
        const float bias = a.in[28][g * 128 + t];
#pragma unroll
        for (int cb = 0; cb < 8; ++cb) { const size_t off = (r0 + t) * DM + g * 128 + cb * 16 + quad * 4;
            const f32x4 sp = acc[cb] + bias; u32x2 w; w.x = cvt_pk_bf16(bf2f(uw[cb].x & 0xffff) * sp[0], bf2f(uw[cb].x >> 16) * sp[1]); w.y = cvt_pk_bf16(bf2f(uw[cb].y & 0xffff) * sp[2], bf2f(uw[cb].y >> 16) * sp[3]);
            *(u32x2*)(UG + off) = w; }
        __syncthreads();
    }
}
__device__ __forceinline__ void gate_sample_unit(ArgsK& a, LAS unsigned char* lds, int b, int g, int tid, int wave, int lane) {
    const bf16_t* VR = (const bf16_t*)(a.ws + WS_VR); const bf16_t* U = (const bf16_t*)(a.ws + WS_U); bf16_t* UG = (bf16_t*)(a.ws + WS_UG);
    LAS float* VL = (LAS float*)lds;
    const size_t rs = (size_t)MP + b * DSEQ;
    for (int rr = 0; rr < 2; ++rr) { const int t = wave * 2 + rr; const bf16_t* vr = VR + (rs + t) * DM; f32x4 v[4]; float s = 0.f;
#pragma unroll
        for (int j = 0; j < 4; ++j) { const u32x2 w_ = ((const u32x2*)vr)[lane + 64 * j]; v[j] = (f32x4){bf2f(w_.x & 0xffff), bf2f(w_.x >> 16), bf2f(w_.y & 0xffff), bf2f(w_.y >> 16)}; s += (v[j][0] + v[j][1]) + (v[j][2] + v[j][3]); }
        const float mean = wave_sum(s) * (1.f / DM); float s2 = 0.f;
#pragma unroll
        for (int j = 0; j < 4; ++j) { const f32x4 d = v[j] - mean; s2 += (d[0] * d[0] + d[1] * d[1]) + (d[2] * d[2] + d[3] * d[3]); }
        const float rstd = rsqrtf(wave_sum(s2) * (1.f / DM) + 1e-5f);
#pragma unroll
        for (int j = 0; j < 4; ++j) if (((lane + 64 * j) >> 5) == g) {
            const int c4 = lane + 64 * j;
            const f32x4 o = (v[j] - mean) * rstd * ((const f32x4*)a.in[25])[c4] + ((const f32x4*)a.in[26])[c4];
            *(LAS f32x4*)(VL + t * 128 + (c4 - 32 * g) * 4) = o; ((f32x4*)(a.out + O_GVS + ((size_t)b * DSEQ + t) * DM))[c4] = o; } }
    __syncthreads();
    { const int c = tid & 127, tq = (tid >> 7) * 4; float vv[16];
#pragma unroll
      for (int s = 0; s < 16; ++s) vv[s] = VL[s * 128 + c];
#pragma unroll
      for (int q = 0; q < 4; ++q) { const int t = tq + q; const float* wr = a.in[27] + ((size_t)(g * 128 + t)) * 128; float sp = a.in[28][g * 128 + t];
#pragma unroll
          for (int s = 0; s < 16; ++s) sp += wr[s] * vv[s];
          const size_t off = (rs + t) * DM + g * 128 + c;
          UG[off] = (bf16_t)(cvt_pk_bf16(bf2f(U[off]) * sp, 0.f) & 0xffffu); } }
    __syncthreads();
}
#define XB_TMO      128
#define XB_XCNT(j)  (256  + 64 * (j))
#define XB_XSUB(j)  (1280 + 64 * (j))
#define XB_XGEN(j)  (2304 + 64 * (j))
#define XB_TOP      3328
#define XB_TOPGEN   3392
#define XCD_BAR_WORDS 3456
#define XB_SPIN_CAP (1u << 18)

__device__ __forceinline__ unsigned xb_ld(unsigned* p)              { return __hip_atomic_load(p, __ATOMIC_RELAXED, __HIP_MEMORY_SCOPE_AGENT); }
__device__ __forceinline__ unsigned xb_add(unsigned* p, unsigned v) { return __hip_atomic_fetch_add(p, v, __ATOMIC_RELAXED, __HIP_MEMORY_SCOPE_AGENT); }
__device__ __forceinline__ unsigned xb_xcc_id() { return (unsigned)__builtin_amdgcn_s_getreg((3 << 11) | 20) & 0xFu; }
#define XB_SPIN(cond, bar) do { unsigned _sp = 0; while (cond) { __builtin_amdgcn_s_sleep(1); \
    if ((++_sp & 255u) == 0u) { if (xb_ld(&(bar)[XB_TMO])) break; if (_sp > XB_SPIN_CAP) { atomicAdd(&(bar)[XB_TMO], 1u); break; } } } } while (0)

struct XcdBarrier {
    unsigned* bar; unsigned x; unsigned G;
    volatile LAS unsigned* st;
};

__device__ __forceinline__ XcdBarrier xcd_barrier_post(unsigned* bar, volatile LAS unsigned* st) {
    XcdBarrier b; b.bar = bar; b.x = xb_xcc_id(); b.st = st; b.G = 0;
    if (threadIdx.x == 0) (void)xb_add(&bar[XB_XCNT(b.x)], 1u);
    return b;
}
__device__ __forceinline__ void xcd_barrier_complete(unsigned* bar, unsigned x, unsigned& nloc, unsigned& nx, const unsigned G) {
    unsigned sum, cnt, mine, sp = 0u;
    for (;;) {
        sum = 0u; cnt = 0u; mine = 0u;
#pragma unroll
        for (unsigned j = 0; j < 16; ++j) { const unsigned c = xb_ld(&bar[XB_XCNT(j)]); sum += c; cnt += (c > 0u) ? 1u : 0u; mine = (j == x) ? c : mine; }
        if (sum == G) break;
        __builtin_amdgcn_s_sleep(1);
        if ((++sp & 255u) == 0u) { if (xb_ld(&bar[XB_TMO])) break; if (sp > XB_SPIN_CAP) { atomicAdd(&bar[XB_TMO], 1u); break; } }
    }
    nloc = mine > 0u ? mine : 1u; nx = cnt > 0u ? cnt : 1u;
}

__device__ __forceinline__ void xcd_barrier(const XcdBarrier& b) {
    asm volatile("s_waitcnt vmcnt(0)" ::: "memory");
    __syncthreads();
    if (threadIdx.x == 0) {
        unsigned* bar = b.bar;
        __builtin_amdgcn_s_waitcnt(0);
        unsigned nloc = b.st[0], nx = b.st[1];
        if (nloc == 0u) { xcd_barrier_complete(bar, b.x, nloc, nx, b.G); b.st[0] = nloc; b.st[1] = nx; }
        const unsigned old = xb_add(&bar[XB_XSUB(b.x)], 1u);
        const unsigned gen = old / nloc;
        if (old + 1u == (gen + 1u) * nloc) {
            __builtin_amdgcn_fence(__ATOMIC_RELEASE, "agent");
            asm volatile("s_waitcnt vmcnt(0)" ::: "memory");
            const unsigned og = xb_add(&bar[XB_TOP], 1u);
            const unsigned tg = og / nx;
            if (og + 1u == (tg + 1u) * nx) xb_add(&bar[XB_TOPGEN], 1u);
            else XB_SPIN(xb_ld(&bar[XB_TOPGEN]) == tg, bar);
            __builtin_amdgcn_fence(__ATOMIC_ACQUIRE, "agent");
            xb_add(&bar[XB_XGEN(b.x)], 1u);
            asm volatile("s_waitcnt vmcnt(0)" ::: "memory");
        } else {
            XB_SPIN(xb_ld(&bar[XB_XGEN(b.x)]) == gen, bar);
            __builtin_amdgcn_fence(__ATOMIC_ACQUIRE, "agent");
            asm volatile("s_waitcnt vmcnt(0)" ::: "memory");
        }
    }
    __syncthreads();
}

constexpr int N_PHASES = 23;
template <class Epi> __device__ __forceinline__ void run_gemm(LAS unsigned char* lds, const bf16_t* A, const bf16_t* Bt, int N, int K, const Epi& E, int G, int bid, int tid) {
    pg8::Gemm g{A, Bt, M, N, K}; pg8::StaticOrder S; S.init(M, N, G, bid);
    pg8::gemm_phase<Epi, pg8::StaticOrder>(lds, g, S, E, tid);
}
__global__ void __launch_bounds__(512, 2) mega_fwd(Args a_) {
    extern __shared__ __attribute__((aligned(16))) unsigned char lds_raw[];
    LAS unsigned char* lds = (LAS unsigned char*)lds_raw;
    if (threadIdx.x < 2) ((volatile LAS unsigned*)(lds + 131072 + 64))[threadIdx.x] = 0u;
    __syncthreads();
    XcdBarrier gbar = xcd_barrier_post((unsigned*)(a_.ws + WS_CTL), (volatile LAS unsigned*)(lds + 131072 + 64)); gbar.G = (unsigned)a_.G;
    const int ph_lo = a_.ph_lo, ph_hi = a_.ph_hi;
    for (int ph = ph_lo; ph < ph_hi; ++ph) {
        ArgsK* ap = (ArgsK*)__builtin_amdgcn_kernarg_segment_ptr();
        asm volatile("" : "+s"(ap));
        ArgsK& a = *ap;
        unsigned char* ws = a.ws;
        int tid = threadIdx.x; asm volatile("" : "+v"(tid));
        int bid = blockIdx.x, G = a.G; asm volatile("" : "+s"(bid), "+s"(G));
        const int lane = tid & 63, wave = __builtin_amdgcn_readfirstlane(tid >> 6), gw = bid * 8 + wave, NGW = G * 8;
        int kind, idx;
        const int rawp = a.seq[ph]; const int php = rawp & 0x7f;
        switch (php) {
            case 0: kind = 0; idx = 0; break;
            case 1: kind = 1; idx = 0; break;  case 2: kind = 2; idx = 0; break;  case 3: kind = 3; idx = 0; break;
            case 4: kind = 4; idx = 0; break;  case 5: kind = 5; idx = 0; break;  case 6: kind = 6; idx = 0; break;  case 7: kind = 7; idx = 0; break;
            case 8: kind = 2; idx = 4; break;  case 9: kind = 3; idx = 1; break;
            case 10: kind = 1; idx = 1; break; case 11: kind = 2; idx = 1; break; case 12: kind = 3; idx = 2; break;
            case 13: kind = 1; idx = 2; break; case 14: kind = 2; idx = 2; break; case 15: kind = 3; idx = 3; break;
            case 16: kind = 8; idx = 0; break; case 17: kind = 9; idx = 0; break; case 18: kind = 2; idx = 5; break; case 19: kind = 3; idx = 4; break;
            case 20: kind = 1; idx = 3; break; case 21: kind = 2; idx = 3; break; case 22: kind = 3; idx = 5; break; case 24: kind = 7; idx = 1; break; default: kind = 10; idx = 0; break;
        }
        if (kind == 0) phase_prologue(a, lds, gw, NGW, wave, lane);
        else if (kind == 1) { EpiSwiglu E{(bf16_t*)(ws + WS_BIG)}; run_gemm(lds, (const bf16_t*)(ws + WS_HN), (const bf16_t*)(ws + WS_WFI) + (size_t)idx * 2 * DFF * DM, 2 * DFF, DM, E, G, bid, tid); }
        else if (kind == 2 || kind == 6 || kind == 3) { const bool lo = (kind == 6), tail = (kind == 3);
            const int gi = tail ? (idx == 0 ? 0 : idx == 1 ? 4 : idx == 2 ? 1 : idx == 3 ? 2 : idx == 4 ? 5 : 3) : idx;
            EpiF32 E{(bf16_t*)(ws + WS_Y), DM, lo ? 1 : 0, EpiLora{(bf16_t*)(ws + WS_DEC), (bf16_t*)(ws + WS_AA), (bf16_t*)(ws + WS_GG), a.in[13], a.in[15]}};
            const bf16_t* A = lo ? (const bf16_t*)(ws + WS_LA) : (gi < 4 ? (const bf16_t*)(ws + WS_BIG) : (const bf16_t*)(ws + WS_HN));
            const bf16_t* Bt = lo ? (const bf16_t*)(ws + WS_WLO) : (gi < 4 ? (const bf16_t*)(ws + WS_WFO) + (size_t)gi * DM * DFF : (gi == 4 ? (const bf16_t*)(ws + WS_WEO) : (const bf16_t*)(ws + WS_WGO)));
            const int N_ = lo ? 1536 : DM, K_ = lo ? 256 : (gi < 4 ? DFF : DM);
            TailOrder S; S.init(lo ? M : MP, N_, G, bid); S.tmode = tail ? 1 : 0; S.tbid = bid;
            pg8::Gemm g{A, Bt, M, N_, K_};
            pg8::gemm_phase<EpiF32, TailOrder>(lds, g, S, E, tid);
            if (tail) { unsigned* cnt = (unsigned*)(ws + WS_CTL) + CW_TAIL + idx * 64;
                if (bid < N_TAIL) { asm volatile("s_waitcnt vmcnt(0)" ::: "memory"); __syncthreads();
                    if (tid == 0) { __builtin_amdgcn_fence(__ATOMIC_RELEASE, "agent"); asm volatile("s_waitcnt vmcnt(0)" ::: "memory"); (void)__hip_atomic_fetch_add(cnt, 1u, __ATOMIC_RELAXED, __HIP_MEMORY_SCOPE_AGENT); } }
                phase_rownorm(a, idx, bid, G, tid, wave, lane, cnt); }
        }
        else if (kind == 4) { EpiProj E{(bf16_t*)(ws + WS_QB), (bf16_t*)(ws + WS_KB), (bf16_t*)(ws + WS_VB), (bf16_t*)(ws + WS_PR), a.out, a.in[11]}; run_gemm(lds, (const bf16_t*)(ws + WS_HN), (const bf16_t*)(ws + WS_WEI), NEI, DM, E, G, bid, tid); }
        else if (kind == 5) phase_prep(a, gw, NGW, lane);
        else if (kind == 7) {
            if (idx == 0) { for (int i = 0; i < 4; ++i) for (int u = bid; u < 256; u += G) { const int b = u >> 3, h = u & 7;
                    attn_prompt_unit(a, lds, b, h, i, tid, wave, lane); attn_prompt_unit(a, lds, b, h, 7 - i, tid, wave, lane); }
                for (int u = bid; u < 256; u += G) attn_sample_unit(a, lds, u >> 3, u & 7, tid, wave, lane); }
            else for (int u = bid; u < 512; u += G) scan_unit(a, lds, u, tid, wave, lane);
        }
        else if (kind == 8) { EpiGelu E{(bf16_t*)(ws + WS_U), (bf16_t*)(ws + WS_VR)}; run_gemm(lds, (const bf16_t*)(ws + WS_HN), (const bf16_t*)(ws + WS_WGI), 2 * DM, DM, E, G, bid, tid); }
        else if (kind == 9) { for (int n = bid; n < 512; n += G) gate_prompt_unit(a, lds, n, tid, wave, lane);
               for (int u = bid; u < NB * 8; u += G) gate_sample_unit(a, lds, u >> 3, u & 7, tid, wave, lane); }
        if (ph + 1 < ph_hi && !(rawp & 0x80)) { if (a.pad == 0x7fffffff) cg::this_grid().sync();
            xcd_barrier(gbar); }
    }
}
extern "C" void kernel_launch(void* const* d_in, const int* in_sizes, int n_in, void* d_out, int out_size, void* d_ws, size_t ws_size, hipStream_t stream) {
    static int grid = 0;
    if (grid == 0) {
        if (n_in != 30 || (size_t)out_size != O_END || ws_size < WS_END) { fprintf(stderr, "kernel_launch: unexpected shapes (n_in %d, out %d, ws %zu)\n", n_in, out_size, ws_size); grid = -1; return; }
        { static const int exp_sz[30] = {67108864, 524288, 33554432, 33554432, 524288, 1048576, 57344, 12288, 23068672, 11534336, 3416064, 8, 1792, 512, 32768, 512, 32768, 65536, 512, 512, 512, 512, 512, 1048576, 2097152, 1024, 1024, 131072, 1024, 1048576};
          for (int i = 0; i < 30; ++i) if (in_sizes[i] != exp_sz[i]) { fprintf(stderr, "kernel_launch: input %d has %d elements, expected %d\n", i, in_sizes[i], exp_sz[i]); grid = -1; return; } }
        int dev = 0, cus = 0, per_cu = 0;
        (void)hipGetDevice(&dev); (void)hipDeviceGetAttribute(&cus, hipDeviceAttributeMultiprocessorCount, dev);
        if (hipFuncSetAttribute((const void*)mega_fwd, hipFuncAttributeMaxDynamicSharedMemorySize, LDS_BYTES) != hipSuccess) { fprintf(stderr, "kernel_launch: hipFuncSetAttribute failed\n"); grid = -1; return; }
        if (hipOccupancyMaxActiveBlocksPerMultiprocessor(&per_cu, (const void*)mega_fwd, 512, LDS_BYTES) != hipSuccess || per_cu < 1) { fprintf(stderr, "kernel_launch: occupancy query says %d\n", per_cu); per_cu = 1; }
        (void)hipGetLastError();
        grid = cus * 1;
        if (grid > 256) grid = 256;
    }
    if (grid < 0) return;
    Args a{};
    for (int i = 0; i < 30; ++i) a.in[i] = (const float*)d_in[i];
    a.out = (float*)d_out; a.ws = (unsigned char*)d_ws; a.G = grid;
    if (hipMemsetAsync((char*)d_ws + WS_CTL, 0, CTL_BYTES, stream) != hipSuccess) { fprintf(stderr, "kernel_launch: memset of the barrier words failed\n"); return; }
    int nsteps = 0;
    for (int p = 0; p < N_PHASES; ++p) { a.seq[nsteps++] = (unsigned char)(p == 6 ? (6 | 0x80) : p);
        if (p == 7) a.seq[nsteps++] = (unsigned char)24;
#ifdef PROBE_NULLS
        if (p == 0) for (int k = 0; k < PROBE_NULLS; ++k) a.seq[nsteps++] = (unsigned char)23;
#endif
#ifdef PROBE_DUP
        { const int dupl[] = PROBE_DUP; for (unsigned k = 0; k < sizeof(dupl) / sizeof(int); ++k) if (dupl[k] == p) a.seq[nsteps++] = (unsigned char)p; else if (dupl[k] == 24 && p == 7) a.seq[nsteps++] = (unsigned char)24; }
#endif
    }
    a.ph_lo = 0; a.ph_hi = nsteps; void* args[] = {&a};
    hipError_t e = hipLaunchCooperativeKernel((const void*)mega_fwd, dim3(grid), dim3(512), args, LDS_BYTES, stream);
    if (e != hipSuccess) fprintf(stderr, "cooperative launch failed: %s (grid %d)\n", hipGetErrorString(e), grid);
}
```
